# Optimizing an MI355X kernel written in HIP

```python
import jax, jax.numpy as jnp
from jax import lax
import numpy as np

D_MODEL = 1024
BATCH = 16
SEQ = 4096
DEPTH = 4

GRID_W = 64
CTX_LEN = 256
N_MIXERS = 3
N_LAYERS_A = (DEPTH + 2) // 3
N_LAYERS_B = (DEPTH + 1) // 3
N_LAYERS_C = DEPTH // 3

N_FOURIER_GROUPS = 8
FOURIER_GROUP = D_MODEL // N_FOURIER_GROUPS

HEAD_DIM = 128
N_HEADS = D_MODEL // HEAD_DIM
N_KV_HEADS = 2
Q_PER_KV = N_HEADS // N_KV_HEADS
ROPE_THETA = 10000.0
Q_BLOCK = 128

D_RNN = 5 * D_MODEL // 4
LRU_BLOCK = 128
N_LRU_BLOCKS = D_RNN // LRU_BLOCK
CONV_W = 4
LRU_C = 8.0

D_FF = 4 * D_MODEL
EPS = 1e-6

kernel_name = 'hybrid_fnet_gqa_rglru_diffusion_trunk'


def _rmsnorm(x, g):
    x32 = x.astype(jnp.float32)
    y = x32 * lax.rsqrt(jnp.mean(x32 * x32, axis=-1, keepdims=True) + EPS)
    return (y * g.astype(jnp.float32)).astype(x.dtype)


def _modulate(h, shift, scale):
    return h * (1 + scale) + shift


def _squared_relu_mlp(h, w1, w2):
    return jnp.square(jax.nn.relu(h @ w1)) @ w2


def _fourier_mixer(h, w_in, w_out):
    B, T, _ = h.shape
    u = (h @ w_in).reshape(B, T, N_FOURIER_GROUPS, FOURIER_GROUP).astype(jnp.float32)
    f = jnp.fft.fft2(u, axes=(1, 3), norm='ortho').real.astype(h.dtype)
    return f.reshape(B, T, D_MODEL) @ w_out


def _axial_angles(n_tokens):
    rows = n_tokens // GRID_W
    row = jnp.repeat(jnp.arange(rows, dtype=jnp.int32), GRID_W)
    col = jnp.tile(jnp.arange(GRID_W, dtype=jnp.int32), rows)
    n_freq = HEAD_DIM // 4
    inv = ROPE_THETA ** (-jnp.arange(n_freq, dtype=jnp.float32) / n_freq)
    ang = jnp.concatenate([row.astype(jnp.float32)[:, None] * inv,
                           col.astype(jnp.float32)[:, None] * inv], axis=-1)
    return jnp.cos(ang), jnp.sin(ang)


def _rope(x, cos, sin):
    xp = x.astype(jnp.float32).reshape(*x.shape[:-1], HEAD_DIM // 2, 2)
    x0, x1 = xp[..., 0], xp[..., 1]
    cs, sn = cos[None, :, None, :], sin[None, :, None, :]
    out = jnp.stack([x0 * cs - x1 * sn, x0 * sn + x1 * cs], axis=-1)
    return out.reshape(x.shape).astype(x.dtype)


def _qkv(h, w_qkv, q_g, k_g):
    B, T, _ = h.shape
    q, k, v = jnp.split(h @ w_qkv, [N_HEADS * HEAD_DIM, (N_HEADS + N_KV_HEADS) * HEAD_DIM], axis=-1)
    q = _rmsnorm(q.reshape(B, T, N_HEADS, HEAD_DIM), q_g)
    k = _rmsnorm(k.reshape(B, T, N_KV_HEADS, HEAD_DIM), k_g)
    v = v.reshape(B, T, N_KV_HEADS, HEAD_DIM)
    return q, k, v


def _attend(q, k, v):
    s = jnp.einsum('bqkgd,bskd->bkgqs', q, k).astype(jnp.float32) * (HEAD_DIM ** -0.5)
    p = jax.nn.softmax(s, axis=-1).astype(v.dtype)
    return jnp.einsum('bkgqs,bskd->bqkgd', p, v)


def _attention_mixer(h_lat, h_ctx, w_qkv, w_o, q_g, k_g, ctx_out):
    B, S, _ = h_lat.shape
    Tc = h_ctx.shape[1]
    cos, sin = _axial_angles(S)
    q_l, k_l, v_l = _qkv(h_lat, w_qkv, q_g, k_g)
    q_l, k_l = _rope(q_l, cos, sin), _rope(k_l, cos, sin)
    q_c, k_c, v_c = _qkv(h_ctx, w_qkv, q_g, k_g)
    k_all = jnp.concatenate([k_l, k_c], axis=1)
    v_all = jnp.concatenate([v_l, v_c], axis=1)
    n_blk = S // Q_BLOCK
    qb = q_l.reshape(B, n_blk, Q_BLOCK, N_KV_HEADS, Q_PER_KV, HEAD_DIM).transpose(1, 0, 2, 3, 4, 5)
    ob = lax.map(lambda qblk: _attend(qblk, k_all, v_all), qb)
    y_l = ob.transpose(1, 0, 2, 3, 4, 5).reshape(B, S, N_HEADS * HEAD_DIM) @ w_o
    y_c = None
    if ctx_out:
        o_c = _attend(q_c.reshape(B, Tc, N_KV_HEADS, Q_PER_KV, HEAD_DIM), k_c, v_c)
        y_c = o_c.reshape(B, Tc, N_HEADS * HEAD_DIM) @ w_o
    return y_l, y_c


def _centred_conv(x, w, b):
    T = x.shape[1]
    left = CONV_W // 2
    xp = jnp.pad(x, ((0, 0), (left, CONV_W - 1 - left), (0, 0)))
    y = b
    for k in range(CONV_W):
        y = y + xp[:, k:k + T] * w[k]
    return y


def _block_diag(x, w, b):
    B, T, _ = x.shape
    xb = x.reshape(B, T, N_LRU_BLOCKS, LRU_BLOCK)
    return jnp.einsum('btnk,nkj->btnj', xb, w).reshape(B, T, D_RNN) + b


def _linear_scan(a, u, h0):
    u = u.at[:, 0].add(a[:, 0] * h0)
    def comb(l, r):
        return (l[0] * r[0], r[0] * l[1] + r[1])
    _, h = lax.associative_scan(comb, (a, u), axis=1)
    return h


def _rglru_dir(x, wa, ba, wx, bx, lam, h0, reverse):
    r = jax.nn.sigmoid(_block_diag(x, wa, ba)).astype(jnp.float32)
    i = jax.nn.sigmoid(_block_diag(x, wx, bx)).astype(jnp.float32)
    log_a = -LRU_C * r * jax.nn.softplus(-lam.astype(jnp.float32))
    a = jnp.exp(log_a)
    u = jnp.sqrt(-jnp.expm1(2.0 * log_a)) * (i * x.astype(jnp.float32))
    if reverse:
        a, u = jnp.flip(a, axis=1), jnp.flip(u, axis=1)
    h = _linear_scan(a, u, h0)
    final = h[:, -1]
    if reverse:
        h = jnp.flip(h, axis=1)
    return h, final


def _lru_mixer(h_lat, h_ctx, w_in, conv_w, conv_b, ga_w, ga_b, gx_w, gx_b, lam, w_out, ctx_out):
    def branches(h):
        g, xr = jnp.split(h @ w_in, 2, axis=-1)
        return jax.nn.gelu(g), _centred_conv(xr, conv_w, conv_b)
    g_c, x_c = branches(h_ctx)
    g_l, x_l = branches(h_lat)
    B = h_lat.shape[0]
    h0 = jnp.zeros((B, D_RNN), jnp.float32)
    rec_l, rec_c = None, None
    for d, rev in enumerate((False, True)):
        p = (ga_w[d], ga_b[d], gx_w[d], gx_b[d], lam[d])
        hc, fin_c = _rglru_dir(x_c, *p, h0, rev)
        hl, _ = _rglru_dir(x_l, *p, fin_c, rev)
        rec_l = hl if rec_l is None else rec_l + hl
        rec_c = hc if rec_c is None else rec_c + hc
    y_l = (g_l * rec_l.astype(g_l.dtype)) @ w_out
    y_c = (g_c * rec_c.astype(g_c.dtype)) @ w_out if ctx_out else None
    return y_l, y_c


def setup_inputs(seed: int = 0) -> dict:
    key = jax.random.key(seed)
    ks = jax.random.split(key, 32)
    f32 = jnp.float32

    def nrm(k, shape, scale):
        return jax.random.normal(k, shape, f32) * scale

    u = jax.random.uniform(ks[24], (N_LAYERS_C, 2, D_RNN), f32, 0.9, 0.999)
    return {
        'x': nrm(ks[0], (BATCH, SEQ, D_MODEL), 1.0),
        'c': nrm(ks[1], (BATCH, D_MODEL), 1.0),
        'ctx': nrm(ks[2], (BATCH, CTX_LEN, D_MODEL), 1.0),
        'c_ctx': nrm(ks[3], (D_MODEL,), 1.0),
        'ada_w': nrm(ks[4], (DEPTH, D_MODEL, 6 * D_MODEL), D_MODEL ** -0.5),
        'ada_b': nrm(ks[5], (DEPTH, 6 * D_MODEL), 0.02),
        'norm_mix_g': 1.0 + nrm(ks[6], (DEPTH, D_MODEL), 0.05),
        'norm_mlp_g': 1.0 + nrm(ks[7], (DEPTH, D_MODEL), 0.05),
        'mlp_w1': nrm(ks[8], (DEPTH, D_MODEL, D_FF), D_MODEL ** -0.5),
        'mlp_w2': nrm(ks[9], (DEPTH, D_FF, D_MODEL), D_FF ** -0.5),
        'fnet_w_in': nrm(ks[10], (N_LAYERS_A, D_MODEL, D_MODEL), D_MODEL ** -0.5),
        'fnet_w_out': nrm(ks[11], (N_LAYERS_A, D_MODEL, D_MODEL), D_MODEL ** -0.5),
        'attn_w_qkv': nrm(ks[12], (N_LAYERS_B, D_MODEL, (N_HEADS + 2 * N_KV_HEADS) * HEAD_DIM), D_MODEL ** -0.5),
        'attn_w_o': nrm(ks[13], (N_LAYERS_B, N_HEADS * HEAD_DIM, D_MODEL), (N_HEADS * HEAD_DIM) ** -0.5),
        'attn_q_norm_g': 1.0 + nrm(ks[14], (N_LAYERS_B, HEAD_DIM), 0.05),
        'attn_k_norm_g': 1.0 + nrm(ks[15], (N_LAYERS_B, HEAD_DIM), 0.05),
        'lru_w_in': nrm(ks[16], (N_LAYERS_C, D_MODEL, 2 * D_RNN), D_MODEL ** -0.5),
        'lru_conv_w': nrm(ks[17], (N_LAYERS_C, CONV_W, D_RNN), CONV_W ** -0.5),
        'lru_conv_b': nrm(ks[18], (N_LAYERS_C, D_RNN), 0.02),
        'lru_gate_a_w': nrm(ks[19], (N_LAYERS_C, 2, N_LRU_BLOCKS, LRU_BLOCK, LRU_BLOCK), LRU_BLOCK ** -0.5),
        'lru_gate_a_b': nrm(ks[20], (N_LAYERS_C, 2, D_RNN), 0.02),
        'lru_gate_x_w': nrm(ks[21], (N_LAYERS_C, 2, N_LRU_BLOCKS, LRU_BLOCK, LRU_BLOCK), LRU_BLOCK ** -0.5),
        'lru_gate_x_b': nrm(ks[22], (N_LAYERS_C, 2, D_RNN), 0.02),
        'lru_lambda': jnp.log(u) - jnp.log1p(-u),
        'lru_w_out': nrm(ks[23], (N_LAYERS_C, D_RNN, D_MODEL), D_RNN ** -0.5),
        'final_norm_g': 1.0 + nrm(ks[25], (D_MODEL,), 0.05),
    }


def reference(x, c, ctx, c_ctx, ada_w, ada_b, norm_mix_g, norm_mlp_g, mlp_w1, mlp_w2,
              fnet_w_in, fnet_w_out, attn_w_qkv, attn_w_o, attn_q_norm_g, attn_k_norm_g,
              lru_w_in, lru_conv_w, lru_conv_b, lru_gate_a_w, lru_gate_a_b, lru_gate_x_w,
              lru_gate_x_b, lru_lambda, lru_w_out, final_norm_g):
    s_lat = jax.nn.silu(c)
    s_ctx = jax.nn.silu(c_ctx)[None]
    for i in range(DEPTH):
        kind = i % N_MIXERS
        j = i // N_MIXERS
        last = i == DEPTH - 1
        ctx_out = not last
        need_ctx_side = ctx_out or kind != 0

        m_l = (s_lat @ ada_w[i] + ada_b[i])[:, None, :]
        sh1, sc1, g1, sh2, sc2, g2 = jnp.split(m_l, 6, axis=-1)
        h_l = _modulate(_rmsnorm(x, norm_mix_g[i]), sh1, sc1)
        h_c = None
        if need_ctx_side:
            m_c = (s_ctx @ ada_w[i] + ada_b[i])[:, None, :]
            csh1, csc1, cg1, csh2, csc2, cg2 = jnp.split(m_c, 6, axis=-1)
            h_c = _modulate(_rmsnorm(ctx, norm_mix_g[i]), csh1, csc1)

        if kind == 0:
            y_l = _fourier_mixer(h_l, fnet_w_in[j], fnet_w_out[j])
            y_c = _fourier_mixer(h_c, fnet_w_in[j], fnet_w_out[j]) if ctx_out else None
        elif kind == 1:
            y_l, y_c = _attention_mixer(h_l, h_c, attn_w_qkv[j], attn_w_o[j],
                                        attn_q_norm_g[j], attn_k_norm_g[j], ctx_out)
        else:
            y_l, y_c = _lru_mixer(h_l, h_c, lru_w_in[j], lru_conv_w[j], lru_conv_b[j],
                                  lru_gate_a_w[j], lru_gate_a_b[j], lru_gate_x_w[j],
                                  lru_gate_x_b[j], lru_lambda[j], lru_w_out[j], ctx_out)

        x = x + g1 * y_l
        x = x + g2 * _squared_relu_mlp(_modulate(_rmsnorm(x, norm_mlp_g[i]), sh2, sc2), mlp_w1[i], mlp_w2[i])
        if ctx_out:
            ctx = ctx + cg1 * y_c
            ctx = ctx + cg2 * _squared_relu_mlp(_modulate(_rmsnorm(ctx, norm_mlp_g[i]), csh2, csc2),
                                                mlp_w1[i], mlp_w2[i])
    return _rmsnorm(x, final_norm_g)
```

```cpp
#include <hip/hip_runtime.h>
#include <hip/hip_cooperative_groups.h>
#include <cstdio>
#include <cstring>
#include <cstdint>
namespace cg = cooperative_groups;

#ifndef MK_LAUNCHES
#define MK_LAUNCHES 1
#endif

#define LAS __attribute__((address_space(3)))
typedef unsigned short bf16_t;
typedef short bf16x8 __attribute__((ext_vector_type(8)));
typedef short s16x4 __attribute__((ext_vector_type(4)));
typedef float f32x4 __attribute__((ext_vector_type(4)));
typedef float f32x16 __attribute__((ext_vector_type(16)));
typedef unsigned u32x4 __attribute__((ext_vector_type(4)));
typedef unsigned u32x2 __attribute__((ext_vector_type(2)));

constexpr int DM = 1024, NBATCH = 16, SEQ = 4096, TCTX = 256, NLAT = NBATCH * SEQ, NCTX = NBATCH * TCTX, NTOK = NLAT + NCTX;
constexpr int DFF = 4096, DRNN = 1280, SKV = SEQ + TCTX;
constexpr int LDS_BYTES = 131072 + 4096 + 8192;

constexpr size_t al256(size_t x) { return (x + 255) & ~(size_t)255; }
constexpr size_t O_MOD = 0;
constexpr size_t O_XB = al256(O_MOD + 4ull * 17 * 6144 * 4);
constexpr size_t O_W1T = O_XB + (size_t)NTOK * DM * 2;
constexpr size_t O_W2T = O_W1T + 4ull * DFF * DM * 2;
constexpr size_t O_WPQT = O_W2T + 4ull * DFF * DM * 2;
constexpr size_t O_FWOT = O_WPQT + 2ull * 2048 * 1024 * 2;
constexpr size_t O_WQKVT = O_FWOT + 2ull * 1024 * 1024 * 2;
constexpr size_t O_WOT = O_WQKVT + 1536ull * 1024 * 2;
constexpr size_t O_LWINT = O_WOT + 1024ull * 1024 * 2;
constexpr size_t O_GATET = O_LWINT + 2560ull * 1024 * 2;
constexpr size_t O_LWOT = O_GATET + 2ull * 2560 * 256 * 2;
constexpr size_t O_D256 = O_LWOT + 1024ull * 1280 * 2;
constexpr size_t O_ROPE = al256(O_D256 + 256ull * 512 * 2);
constexpr size_t O_BAR = al256(O_ROPE + 64ull * 32 * 2 * 4);
constexpr size_t BAR_BYTES = 16384;
constexpr size_t O_TMP = al256(O_BAR + BAR_BYTES);
constexpr size_t O_H = O_TMP;
constexpr size_t O_BIG = O_H + (size_t)NTOK * DM * 2;
constexpr size_t BIG_END = O_BIG + (size_t)NTOK * DFF * 2;
constexpr size_t O_PQTP = O_BIG;
constexpr size_t O_PQTQ = O_PQTP + 8192ull * 4096 * 2;
constexpr size_t O_PQT64 = O_PQTQ + 8192ull * 4096 * 2;
constexpr size_t O_PQTC = O_PQT64 + 256ull * 4096 * 2;
constexpr int KF = 1152;
constexpr size_t O_CST = O_PQTC + 16ull * 1024 * 256 * 2;
constexpr size_t FOLD_CLS = 16640ull * KF * 2;
constexpr size_t O_FOLD = O_CST + 4ull * 1024 * KF * 2;
constexpr size_t O_F = al256(O_FOLD + 2 * FOLD_CLS);
static_assert(O_F + (size_t)NTOK * DM * 2 <= BIG_END, "fourier temporaries");
constexpr size_t O_QKVRAW = O_BIG;
constexpr size_t O_Q = O_QKVRAW + (size_t)NTOK * 1536 * 2;
constexpr size_t O_KB = O_Q + (size_t)NTOK * 1024 * 2;
constexpr size_t O_VB = O_KB + 16ull * SKV * 256 * 2;
static_assert(O_VB + 16ull * SKV * 256 * 2 <= BIG_END, "attention temporaries");
constexpr size_t LRU_SLOT = (size_t)NTOK * DRNN * 2;
constexpr size_t O_XCONV = O_TMP, O_G = O_TMP + LRU_SLOT, O_XR = O_TMP + 2 * LRU_SLOT, O_LA = O_TMP + 3 * LRU_SLOT;
static_assert(O_TMP + 4 * LRU_SLOT <= (1ull << 30), "lru temporaries");
static_assert(LRU_SLOT <= (size_t)NLAT * DM * 4, "U slot fits d_out");
constexpr size_t O_PART = BIG_END;
static_assert(O_PART + 4ull * NCTX * DM * 4 <= (1ull << 30), "ws");
static_assert(O_G >= O_H + (size_t)NTOK * DM * 2, "G must not overlap H");

enum { OP_PREP = 0, OP_NORM_MIX, OP_NORM_MLP, OP_G_PQ, OP_G_DFT, OP_RES_FOUT, OP_G_MLP1, OP_RES_MLP2, OP_G_QKV, OP_QKNORM, OP_ATTN, OP_RES_WO,
       OP_G_LRUIN, OP_CONV, OP_G_GATE0, OP_SCAN0, OP_G_GATE1, OP_SCAN1, OP_RES_LOUT, OP_FINAL, OP_G_DFTC, OP_FOLD };

struct Params {
    const float *x, *c, *ctx, *c_ctx, *ada_w, *ada_b, *norm_mix_g, *norm_mlp_g, *mlp_w1, *mlp_w2, *fnet_w_in, *fnet_w_out, *attn_w_qkv, *attn_w_o, *q_g, *k_g,
        *lru_w_in, *conv_w, *conv_b, *ga_w, *ga_b, *gx_w, *gx_b, *lam, *lru_w_out, *final_g;
    float* out; unsigned char* ws;
    unsigned char op[48]; unsigned char lay[48];
};

__device__ __forceinline__ unsigned cvtpk(float lo, float hi) { unsigned r; asm volatile("v_cvt_pk_bf16_f32 %0, %1, %2" : "=v"(r) : "v"(lo), "v"(hi)); return r; }
__device__ __forceinline__ float bflo(unsigned w) { return __uint_as_float(w << 16); }
__device__ __forceinline__ float bfhi(unsigned w) { return __uint_as_float(w & 0xffff0000u); }
__device__ __forceinline__ float bf1(bf16_t h) { return __uint_as_float(((unsigned)h) << 16); }
__device__ __forceinline__ bf16_t f2bf(float f) { return (bf16_t)(cvtpk(f, 0.f) & 0xffffu); }
__device__ __forceinline__ float lane_xor(float v, int lane, int o) { return __int_as_float(__builtin_amdgcn_ds_bpermute((lane ^ o) << 2, __float_as_int(v))); }
__device__ __forceinline__ float wave_sum(float v, int lane) {
#pragma unroll
    for (int o = 32; o >= 1; o >>= 1) v += lane_xor(v, lane, o);
    return v;
}
__device__ __forceinline__ int ltid(const int wv) {
    int lane; asm volatile("v_mbcnt_lo_u32_b32 %0, -1, 0\n\tv_mbcnt_hi_u32_b32 %0, -1, %0" : "=v"(lane));
    int t = (wv << 6) | lane; asm volatile("" : "+v"(t)); return t; }
__device__ __forceinline__ float sigmoidf_(float z) { return 1.f / (1.f + __expf(-z)); }

#define XB_TMO      128
#define XB_XCNT(j)  (256  + 64 * (j))
#define XB_XSUB(j)  (1280 + 64 * (j))
#define XB_XGEN(j)  (2304 + 64 * (j))
#define XB_TOP      3328
#define XB_TOPGEN   3392
#define XCD_BAR_WORDS 3456
#define XB_SPIN_CAP (1u << 18)
__device__ __forceinline__ unsigned xb_ld(unsigned* p)              { return __hip_atomic_load(p, __ATOMIC_RELAXED, __HIP_MEMORY_SCOPE_AGENT); }
__device__ __forceinline__ unsigned xb_add(unsigned* p, unsigned v) { return __hip_atomic_fetch_add(p, v, __ATOMIC_RELAXED, __HIP_MEMORY_SCOPE_AGENT); }
__device__ __forceinline__ unsigned xb_xcc_id() { return (unsigned)__builtin_amdgcn_s_getreg((3 << 11) | 20) & 0xFu; }
#define XB_SPIN(cond, bar) do { unsigned _sp = 0; while (cond) { __builtin_amdgcn_s_sleep(1); \
    if ((++_sp & 255u) == 0u) { if (xb_ld(&(bar)[XB_TMO])) break; if (_sp > XB_SPIN_CAP) { atomicAdd(&(bar)[XB_TMO], 1u); break; } } } } while (0)
__device__ __forceinline__ void xcd_barrier_complete(unsigned* bar, unsigned x, unsigned& nloc, unsigned& nx) {
    const unsigned G = gridDim.x * gridDim.y * gridDim.z;
    unsigned sum, cnt, mine, sp = 0u;
    for (;;) {
        sum = 0u; cnt = 0u; mine = 0u;
#pragma unroll
        for (unsigned j = 0; j < 16; ++j) { const unsigned c = xb_ld(&bar[XB_XCNT(j)]); sum += c; cnt += (c > 0u) ? 1u : 0u; mine = (j == x) ? c : mine; }
        if (sum == G) break;
        __builtin_amdgcn_s_sleep(1);
        if ((++sp & 255u) == 0u) { if (xb_ld(&bar[XB_TMO])) break; if (sp > XB_SPIN_CAP) { atomicAdd(&bar[XB_TMO], 1u); break; } }
    }
    nloc = mine > 0u ? mine : 1u; nx = cnt > 0u ? cnt : 1u;
}
__device__ __forceinline__ void xcd_barrier(const int wv, unsigned* bar, volatile LAS unsigned* st) {
    asm volatile("s_waitcnt vmcnt(0)" ::: "memory");
    __syncthreads();
    if (ltid(wv) == 0) {
        const unsigned x = xb_xcc_id();
        __builtin_amdgcn_s_waitcnt(0);
        unsigned nloc = st[0], nx = st[1];
        if (nloc == 0u) { xcd_barrier_complete(bar, x, nloc, nx); st[0] = nloc; st[1] = nx; }
        const unsigned old = xb_add(&bar[XB_XSUB(x)], 1u);
        const unsigned gen = old / nloc;
        if (old + 1u == (gen + 1u) * nloc) {
            __builtin_amdgcn_fence(__ATOMIC_RELEASE, "agent");
            asm volatile("s_waitcnt vmcnt(0)" ::: "memory");
            const unsigned og = xb_add(&bar[XB_TOP], 1u);
            const unsigned tg = og / nx;
            if (og + 1u == (tg + 1u) * nx) xb_add(&bar[XB_TOPGEN], 1u);
            else XB_SPIN(xb_ld(&bar[XB_TOPGEN]) == tg, bar);
            __builtin_amdgcn_fence(__ATOMIC_ACQUIRE, "agent");
            xb_add(&bar[XB_XGEN(x)], 1u);
            asm volatile("s_waitcnt vmcnt(0)" ::: "memory");
        } else {
            XB_SPIN(xb_ld(&bar[XB_XGEN(x)]) == gen, bar);
            __builtin_amdgcn_fence(__ATOMIC_ACQUIRE, "agent");
            asm volatile("s_waitcnt vmcnt(0)" ::: "memory");
        }
    }
    __syncthreads();
}

namespace pg8 {
constexpr int BM = 256, BK = 64, HALF = 128, HTB = HALF * BK * 2, STAGE_BYTES = 8 * HTB, NXCD = 8, WGM = 8;
__device__ __forceinline__ int lds_byte(int r, int c) { const int st = (r >> 4) * 2 + (c >> 5), rr = r & 15, cc = c & 31, ob = rr * 64 + cc * 2; return st * 1024 + (ob ^ (((ob >> 9) & 1) << 5)); }
__device__ __forceinline__ void stage_rc(int b, int& R, int& C) { const int st = b / 1024, sb = b % 1024, swz = sb ^ (((sb >> 9) & 1) << 5); R = (st >> 1) * 16 + swz / 64; C = (st & 1) * 32 + (swz % 64) / 2; }
__device__ __forceinline__ int perm32(int rho) { const int n = rho >> 4, i = rho & 15; return 8 * (i >> 2) + 4 * n + (i & 3); }
struct Unit { int pm, pn, koff, koffB, ks; };
struct Gemm { const bf16_t* A; const bf16_t* Bt; int M, N, K, lda, ldb; };
struct StaticOrder {
    int nM, nN, nwg, G, c;
    __device__ void init(int M, int N, int G_, int c_) { nM = M / BM; nN = N / BM; nwg = nM * nN; G = G_; c = c_; }
    __device__ bool next(int i, Unit& u) const {
        const long L = (long)i * G + c; if (L >= nwg) return false;
        int wgid = (int)L; { const int q = nwg / NXCD, r = nwg % NXCD, xcd = wgid % NXCD, off = wgid / NXCD; wgid = (xcd < r ? xcd * (q + 1) : r * (q + 1) + (xcd - r) * q) + off; }
        const int nig = WGM * nN, gid = wgid / nig, fm = gid * WGM, gsz = (nM - fm) < WGM ? (nM - fm) : WGM;
        u.pm = fm + ((wgid % nig) % gsz); u.pn = (wgid % nig) / gsz; u.koff = 0; u.koffB = 0; u.ks = 0; return true;
    }
};
struct DftOrder : StaticOrder {
    int kq, kcls;
    __device__ bool next(int i, Unit& u) const { if (!StaticOrder::next(i, u)) return false; u.koff = (u.pn >= 32) ? kq : 0; u.koffB = (u.pm >> 2) * kcls; return true; }
};
struct ResOrder : StaticOrder {
    int split;
    __device__ bool next(int i, Unit& u) const { if (!StaticOrder::next(i, u)) return false; if (split) { const int ks = u.pn >> 2; u.pn &= 3; u.koff = ks * 2048; u.koffB = ks * 2048; u.ks = ks; } return true; }
};
struct GateOrder : StaticOrder {
    __device__ bool next(int i, Unit& u) const { if (!StaticOrder::next(i, u)) return false; u.koff = (u.pn >> 1) * 512; return true; }
};

template <class Epi, class Sched>
__device__ __forceinline__ void gemm_phase(const int wv, LAS unsigned char* lds, const Gemm g, const Sched& S, const Epi& E) {
    const int tid = ltid(wv), wid = __builtin_amdgcn_readfirstlane(tid >> 6), lane = tid & 63, wr = wid >> 2, wc = wid & 3, fr = lane & 15, fq = lane >> 4;
    const int K = g.K, nt = K / BK, lda = g.lda, ldb = g.ldb;
    unsigned voffA[2], voffB[2];
#pragma unroll
    for (int i = 0; i < 2; ++i) { int R, C; stage_rc(tid * 16 + i * 8192, R, C); const int Rb = Epi::PERM ? ((R & ~31) + perm32(R & 31)) : R; voffA[i] = (unsigned)(R * lda + C) * 2u; voffB[i] = (unsigned)(Rb * ldb + C) * 2u; }
    const size_t kstep = (size_t)(BK * 2);
    const size_t hstepA = (size_t)HALF * lda * 2, hstepB = (size_t)HALF * ldb * 2;
    const size_t tstepA = 2 * hstepA, tstepB = 2 * hstepB;
    const unsigned ldsw = (unsigned)wid * 1024u;
    const int aoff = lds_byte(wr * 64 + fr, fq * 8), boff = lds_byte(wc * 32 + fr, fq * 8);
#define PG8_SA(b, h) (((b) * 2 + (h)) * HTB)
#define PG8_SB(b, h) ((4 + (b) * 2 + (h)) * HTB)
#define PG8_STAGE(bufoff, gbase, voff) do { _Pragma("unroll") for (int _i = 0; _i < 2; ++_i) \
        __builtin_amdgcn_global_load_lds((const unsigned*)((const char*)(gbase) + (voff)[_i]), (LAS unsigned*)(lds + (bufoff) + ldsw + _i * 8192), 16, 0, 0); } while (0)
#define PG8_LDA(dst, b, h) do { _Pragma("unroll") for (int m = 0; m < 4; ++m) _Pragma("unroll") for (int k = 0; k < 2; ++k) dst[m][k] = *(const LAS bf16x8*)(lds + PG8_SA(b, h) + aoff + m * 2048 + k * 1024); } while (0)
#define PG8_LDB(dst, b, h) do { _Pragma("unroll") for (int n = 0; n < 2; ++n) _Pragma("unroll") for (int k = 0; k < 2; ++k) dst[n][k] = *(const LAS bf16x8*)(lds + PG8_SB(b, h) + boff + n * 2048 + k * 1024); } while (0)
#define PG8_MMA(ai, bj, At, Bt) do { __builtin_amdgcn_s_setprio(1); _Pragma("unroll") for (int m = 0; m < 4; ++m) _Pragma("unroll") for (int n = 0; n < 2; ++n) _Pragma("unroll") for (int k = 0; k < 2; ++k) \
        acc[ai][bj][m][n] = __builtin_amdgcn_mfma_f32_16x16x32_bf16(Bt[n][k], At[m][k], acc[ai][bj][m][n], 0, 0, 0); __builtin_amdgcn_s_setprio(0); } while (0)
#define PG8_WAIT_V(n) asm volatile("s_waitcnt vmcnt(" #n ")" ::: "memory")
#define PG8_WAIT_L(n) asm volatile("s_waitcnt lgkmcnt(" #n ")" ::: "memory")
#define PG8_BAR __builtin_amdgcn_s_barrier()
#define PG8_SCHED __builtin_amdgcn_sched_barrier(0)
    Unit cur, nxt; int ui = 0;
    if (!S.next(0, cur)) return;
    f32x4 acc[2][2][4][2];
#pragma unroll
    for (int a = 0; a < 2; ++a)
#pragma unroll
        for (int b = 0; b < 2; ++b)
#pragma unroll
            for (int m = 0; m < 4; ++m)
#pragma unroll
                for (int n = 0; n < 2; ++n) acc[a][b][m][n] = (f32x4){0.f, 0.f, 0.f, 0.f};
    bf16x8 At[4][2], B0[2][2], B1[2][2];
    const char* cA = (const char*)g.A + (size_t)cur.pm * tstepA + cur.koff; const char* cB = (const char*)g.Bt + (size_t)cur.pn * tstepB + cur.koffB;
    PG8_STAGE(PG8_SB(0, 0), cB, voffB); PG8_STAGE(PG8_SA(0, 0), cA, voffA); PG8_STAGE(PG8_SB(0, 1), cB + hstepB, voffB); PG8_STAGE(PG8_SA(0, 1), cA + hstepA, voffA);
    if (wr == 1) PG8_BAR;
    PG8_WAIT_V(4); PG8_BAR;
    PG8_STAGE(PG8_SB(1, 0), cB + kstep, voffB); PG8_STAGE(PG8_SA(1, 0), cA + kstep, voffA); PG8_STAGE(PG8_SB(1, 1), cB + hstepB + kstep, voffB);
    PG8_WAIT_V(6); PG8_BAR;
    for (;;) {
        const bool has_next = S.next(ui + 1, nxt);
        const char* nA = has_next ? (const char*)g.A + (size_t)nxt.pm * tstepA + nxt.koff : cA; const char* nB = has_next ? (const char*)g.Bt + (size_t)nxt.pn * tstepB + nxt.koffB : cB;
        for (int t = 0; t < nt; t += 2) {
            const bool last = (t == nt - 2);
            const char* a1 = cA + (size_t)(t + 1) * kstep;
            const char* a2 = last ? nA : cA + (size_t)(t + 2) * kstep; const char* b2 = last ? nB : cB + (size_t)(t + 2) * kstep;
            const char* a3 = a2 + kstep; const char* b3 = b2 + kstep;
            PG8_LDB(B0, 0, 0); PG8_SCHED; PG8_LDA(At, 0, 0); PG8_STAGE(PG8_SA(1, 1), a1 + hstepA, voffA);
            PG8_WAIT_L(8); PG8_BAR; PG8_WAIT_L(0); PG8_MMA(0, 0, At, B0); PG8_BAR; PG8_SCHED;
            PG8_LDB(B1, 0, 1); PG8_STAGE(PG8_SB(0, 0), b2, voffB);
            PG8_BAR; PG8_WAIT_L(0); PG8_MMA(0, 1, At, B1); PG8_BAR;
            PG8_LDA(At, 0, 1); PG8_STAGE(PG8_SA(0, 0), a2, voffA);
            PG8_BAR; PG8_WAIT_L(0); PG8_MMA(1, 0, At, B0); PG8_BAR; PG8_SCHED;
            PG8_STAGE(PG8_SB(0, 1), b2 + hstepB, voffB);
            PG8_WAIT_V(6); PG8_BAR; PG8_MMA(1, 1, At, B1); PG8_BAR;
            PG8_LDB(B0, 1, 0); PG8_SCHED; PG8_LDA(At, 1, 0); PG8_STAGE(PG8_SA(0, 1), a2 + hstepA, voffA);
            PG8_WAIT_L(8); PG8_BAR; PG8_WAIT_L(0); PG8_MMA(0, 0, At, B0); PG8_BAR; PG8_SCHED;
            PG8_LDB(B1, 1, 1); PG8_STAGE(PG8_SB(1, 0), b3, voffB);
            PG8_BAR; PG8_WAIT_L(0); PG8_MMA(0, 1, At, B1); PG8_BAR;
            PG8_LDA(At, 1, 1); PG8_STAGE(PG8_SA(1, 0), a3, voffA);
            PG8_BAR; PG8_WAIT_L(0); PG8_MMA(1, 0, At, B0); PG8_BAR; PG8_SCHED;
            PG8_STAGE(PG8_SB(1, 1), b3 + hstepB, voffB);
            PG8_WAIT_V(6); PG8_BAR; PG8_MMA(1, 1, At, B1); PG8_BAR;
        }
        E(acc, cur, wr, wc, fr, fq);
        if (!has_next) break;
#pragma unroll
        for (int a = 0; a < 2; ++a)
#pragma unroll
            for (int b = 0; b < 2; ++b)
#pragma unroll
                for (int m = 0; m < 4; ++m)
#pragma unroll
                    for (int n = 0; n < 2; ++n) acc[a][b][m][n] = (f32x4){0.f, 0.f, 0.f, 0.f};
        cur = nxt; cA = nA; cB = nB; ++ui;
    }
    PG8_WAIT_V(0);
    if (wr == 0) PG8_BAR;
    PG8_BAR;
#undef PG8_SA
#undef PG8_SB
#undef PG8_STAGE
#undef PG8_LDA
#undef PG8_LDB
#undef PG8_MMA
#undef PG8_WAIT_V
#undef PG8_WAIT_L
#undef PG8_BAR
#undef PG8_SCHED
}
}
using pg8::Unit;
typedef f32x4 Acc[2][2][4][2];

__device__ __forceinline__ void st_bf4(bf16_t* p, f32x4 v) { u32x2 w = {cvtpk(v[0], v[1]), cvtpk(v[2], v[3])}; *(u32x2*)p = w; }
__device__ __forceinline__ void st_bf8(bf16_t* p, f32x4 a, f32x4 b) { u32x4 w = {cvtpk(a[0], a[1]), cvtpk(a[2], a[3]), cvtpk(b[0], b[1]), cvtpk(b[2], b[3])}; *(u32x4*)p = w; }
__device__ __forceinline__ void st_bf8_o(bf16_t* base, unsigned eoff, f32x4 a, f32x4 b) { u32x4 w = {cvtpk(a[0], a[1]), cvtpk(a[2], a[3]), cvtpk(b[0], b[1]), cvtpk(b[2], b[3])}; *(u32x4*)((char*)base + (size_t)(eoff * 2u)) = w; }
__device__ __forceinline__ u32x4 ld_bf8_o(const bf16_t* base, unsigned eoff) { return *(const u32x4*)((const char*)base + (size_t)(eoff * 2u)); }
__device__ __forceinline__ void st_bf4_o(bf16_t* base, unsigned eoff, f32x4 v) { u32x2 w = {cvtpk(v[0], v[1]), cvtpk(v[2], v[3])}; *(u32x2*)((char*)base + (size_t)(eoff * 2u)) = w; }

struct EpiBf16 {
    static constexpr bool PERM = false;
    bf16_t* O; int ldc;
    __device__ __forceinline__ void operator()(const Acc& acc, const Unit& u, int wr, int wc, int fr, int fq) const {
        const int row0 = u.pm * 256 + wr * 64 + fr, col0 = u.pn * 256 + wc * 32 + 4 * fq;
#pragma unroll
        for (int ai = 0; ai < 2; ++ai)
#pragma unroll
            for (int m = 0; m < 4; ++m) { bf16_t* rp = O + (size_t)(row0 + ai * 128 + m * 16) * ldc + col0;
#pragma unroll
                for (int bj = 0; bj < 2; ++bj)
#pragma unroll
                    for (int n = 0; n < 2; ++n) st_bf4(rp + bj * 128 + n * 16, acc[ai][bj][m][n]); }
    }
};
struct EpiRelu2 {
    static constexpr bool PERM = true;
    bf16_t* O; int ldc;
    __device__ __forceinline__ void operator()(const Acc& acc, const Unit& u, int wr, int wc, int fr, int fq) const {
        const int row0 = u.pm * 256 + wr * 64 + fr, col0 = u.pn * 256 + wc * 32 + 8 * fq;
#pragma unroll
        for (int ai = 0; ai < 2; ++ai)
#pragma unroll
            for (int m = 0; m < 4; ++m) { bf16_t* rp = O + (size_t)(row0 + ai * 128 + m * 16) * ldc + col0;
#pragma unroll
                for (int bj = 0; bj < 2; ++bj) { f32x4 v0 = acc[ai][bj][m][0], v1 = acc[ai][bj][m][1];
#pragma unroll
                    for (int j = 0; j < 4; ++j) { const float t0 = fmaxf(v0[j], 0.f), t1 = fmaxf(v1[j], 0.f); v0[j] = t0 * t0; v1[j] = t1 * t1; }
                    const u32x4 w = {cvtpk(v0[0], v0[1]), cvtpk(v0[2], v0[3]), cvtpk(v1[0], v1[1]), cvtpk(v1[2], v1[3])};
                    *(u32x4*)(rp + bj * 128) = w; } }
    }
};
struct EpiPQT {
    static constexpr bool PERM = true;
    bf16_t* PP; bf16_t* PQ; bf16_t* P64; bf16_t* PC;
    __device__ __forceinline__ void operator()(const Acc& acc, const Unit& u, int wr, int wc, int fr_, int fq_) const {
        int fr = fr_, fq = fq_; asm volatile("" : "+v"(fr), "+v"(fq));
        const int row0 = u.pm * 256 + wr * 64 + fr, tok0 = u.pn * 256; const bool lat = tok0 < NLAT;
        const int b = lat ? (tok0 >> 12) : ((tok0 - NLAT) >> 8); const int c0 = (lat ? (tok0 & 4095) : 0) + wc * 32 + 8 * fq;
#pragma unroll
        for (int ai = 0; ai < 2; ++ai)
#pragma unroll
            for (int m = 0; m < 4; ++m) { const int n = row0 + ai * 128 + m * 16; bf16_t* rp;
                if (lat) rp = (n < 512 ? PP + (size_t)(b * 512 + n) * 4096 : n < 520 ? P64 + (size_t)(b * 8 + n - 512) * 4096 : PQ + (size_t)(b * 504 + n - 520) * 4096) + c0;
                else rp = PC + (size_t)(b * 1024 + n) * 256 + c0;
#pragma unroll
                for (int bj = 0; bj < 2; ++bj) st_bf8(rp + bj * 128, acc[ai][bj][m][0], acc[ai][bj][m][1]); }
    }
};
struct EpiDFTS {
    static constexpr bool PERM = true;
    bf16_t* F; float scale; int mode;
    __device__ __forceinline__ void operator()(const Acc& acc, const Unit& u, int wr, int wc, int fr_, int fq_) const {
        int fr = fr_, fq = fq_; asm volatile("" : "+v"(fr), "+v"(fq));
        const int r0 = wr * 64 + fr;
#pragma unroll
        for (int bj = 0; bj < 2; ++bj) { const int cl = wc * 32 + 8 * fq + bj * 128; int base; bool ok = true; float sgn = 1.f;
            if (mode == 0) { int bb, n;
                if (u.pn < 32) { const int c = u.pn * 256 + cl; bb = c >> 9; n = c & 511; }
                else { const int c = (u.pn - 32) * 256 + cl; ok = c < 8064; bb = c / 504; n = 520 + c - bb * 504; sgn = -1.f; }
                base = bb * (4096 * 1024) + n; }
            else if (mode == 1) { ok = (cl < 128) && (u.pn == 0); base = (cl >> 3) * (4096 * 1024) + 512 + (cl & 7); }
            else { const int c = u.pn * 256 + cl; const int bb = c >> 10, n = c & 1023; ok = (u.pm == 0) ? (n < 520) : (n >= 520); base = (NLAT + bb * 256) * 1024 + n; }
            if (ok) {
#pragma unroll
                for (int ai = 0; ai < 2; ++ai)
#pragma unroll
                    for (int m = 0; m < 4; ++m) { const f32x4 v0 = acc[ai][bj][m][0] * scale, v1 = acc[ai][bj][m][1] * scale; const int kk = r0 + ai * 128 + m * 16;
                        if (mode == 2) st_bf8_o(F, (unsigned)(base + kk * 1024), v0, v1);
                        else { const int k = 2 * ((u.pm & 3) * 256 + kk) + (u.pm >> 2); st_bf8_o(F, (unsigned)(base + k * 1024), v0, v1); if (k != 0) st_bf8_o(F, (unsigned)(base + (4096 - k) * 1024), v0 * sgn, v1 * sgn); } } }
            __builtin_amdgcn_sched_barrier(0); }
    }
};
struct EpiRes {
    static constexpr bool PERM = true;
    bf16_t* xb; const float* gate;
    float* part;
    __device__ __forceinline__ void operator()(const Acc& acc, const Unit& u, int wr, int wc, int fr_, int fq_) const {
        int fr = fr_, fq = fq_; asm volatile("" : "+v"(fr), "+v"(fq));
        if (part) { float* pp = part + ((size_t)u.ks * NCTX + u.pm * 256 + wr * 64 + fr) * 1024 + u.pn * 256 + wc * 32 + 8 * fq;
#pragma unroll
            for (int ai = 0; ai < 2; ++ai)
#pragma unroll
                for (int m = 0; m < 4; ++m)
#pragma unroll
                    for (int bj = 0; bj < 2; ++bj)
#pragma unroll
                        for (int n = 0; n < 2; ++n) *(f32x4*)(pp + (size_t)(ai * 128 + m * 16) * 1024 + bj * 128 + n * 4) = acc[ai][bj][m][n];
            return; }
        const int R0 = u.pm * 256; const int bidx = R0 < NLAT ? (R0 >> 12) : 16;
        const int r0 = wr * 64 + fr, col0 = u.pn * 256 + wc * 32 + 8 * fq; const float* gp = gate + bidx * 6144 + col0;
        const unsigned xo = (unsigned)((R0 + r0) * 1024 + col0);
        u32x4 xa[4], xq[4]; f32x4 g4[2][2];
#define RES_LOAD(X, BJ, AI) do { _Pragma("unroll") for (int m = 0; m < 4; ++m) X[m] = ld_bf8_o(xb, xo + (unsigned)(((AI) * 128 + m * 16) * 1024 + (BJ) * 128)); } while (0)
#define RES_PROC(X, BJ, AI) do { _Pragma("unroll") for (int m = 0; m < 4; ++m) { \
            const f32x4 x0 = (f32x4){bflo(X[m][0]), bfhi(X[m][0]), bflo(X[m][1]), bfhi(X[m][1])}, x1 = (f32x4){bflo(X[m][2]), bfhi(X[m][2]), bflo(X[m][3]), bfhi(X[m][3])}; \
            st_bf8_o(xb, xo + (unsigned)(((AI) * 128 + m * 16) * 1024 + (BJ) * 128), x0 + g4[BJ][0] * acc[AI][BJ][m][0], x1 + g4[BJ][1] * acc[AI][BJ][m][1]); } } while (0)
        RES_LOAD(xa, 0, 0);
#pragma unroll
        for (int bj = 0; bj < 2; ++bj)
#pragma unroll
            for (int n = 0; n < 2; ++n) g4[bj][n] = *(const f32x4*)(gp + bj * 128 + n * 4);
        RES_LOAD(xq, 0, 1); __builtin_amdgcn_sched_barrier(0);
        RES_PROC(xa, 0, 0); __builtin_amdgcn_sched_barrier(0);
        RES_LOAD(xa, 1, 0); __builtin_amdgcn_sched_barrier(0);
        RES_PROC(xq, 0, 1); __builtin_amdgcn_sched_barrier(0);
        RES_LOAD(xq, 1, 1); __builtin_amdgcn_sched_barrier(0);
        RES_PROC(xa, 1, 0); __builtin_amdgcn_sched_barrier(0);
        RES_PROC(xq, 1, 1);
#undef RES_LOAD
#undef RES_PROC
    }
};
__device__ __forceinline__ float gelu_tanh(float x) { const float z = 0.7978845608028654f * (x + 0.044715f * x * x * x); const float t = 1.f - 2.f * __builtin_amdgcn_rcpf(__expf(2.f * z) + 1.f); return 0.5f * x * (1.f + t); }
struct EpiLruIn {
    static constexpr bool PERM = true;
    bf16_t* G; bf16_t* XR;
    __device__ __forceinline__ void operator()(const Acc& acc, const Unit& u, int wr, int wc, int fr, int fq) const {
        const int row0 = u.pm * 256 + wr * 64 + fr; const int C0 = u.pn * 256; const bool isg = C0 < DRNN;
        bf16_t* base = isg ? G : XR; const int col0 = (isg ? C0 : C0 - DRNN) + wc * 32 + 8 * fq;
#pragma unroll
        for (int ai = 0; ai < 2; ++ai)
#pragma unroll
            for (int m = 0; m < 4; ++m) { bf16_t* rp = base + (size_t)(row0 + ai * 128 + m * 16) * DRNN + col0;
#pragma unroll
                for (int bj = 0; bj < 2; ++bj) { f32x4 v0 = acc[ai][bj][m][0], v1 = acc[ai][bj][m][1];
                    if (isg) {
#pragma unroll
                        for (int j = 0; j < 4; ++j) { v0[j] = gelu_tanh(v0[j]); v1[j] = gelu_tanh(v1[j]); } }
                    st_bf8(rp + bj * 128, v0, v1); } }
    }
};
struct EpiGate {
    static constexpr bool PERM = true;
    const bf16_t* XC; bf16_t* LA; bf16_t* U; const float* ba; const float* bx; const float* lam;
    __device__ __forceinline__ void operator()(const Acc& acc, const Unit& u, int wr, int wc, int fr_, int fq_) const {
        int fr = fr_, fq = fq_; asm volatile("" : "+v"(fr), "+v"(fq));
        constexpr float L2E = 1.4426950408889634f;
        const int row0 = u.pm * 256 + wr * 64 + fr; const int ch0 = u.pn * 128 + wc * 32 + 8 * fq;
        u32x4 xall[4]; f32x4 ba4[2], bx4[2], sp4[2];
#pragma unroll
        for (int n = 0; n < 2; ++n) { ba4[n] = *(const f32x4*)(ba + ch0 + n * 4); bx4[n] = *(const f32x4*)(bx + ch0 + n * 4); sp4[n] = *(const f32x4*)(lam + ch0 + n * 4); }
#pragma unroll
        for (int m = 0; m < 4; ++m) xall[m] = ld_bf8_o(XC, (unsigned)((row0 + m * 16) * DRNN + ch0));
        __builtin_amdgcn_sched_barrier(0);
#pragma unroll
        for (int n = 0; n < 2; ++n) { ba4[n] = ba4[n] * (-L2E); bx4[n] = bx4[n] * (-L2E);
#pragma unroll
            for (int j = 0; j < 4; ++j) sp4[n][j] = -8.f * __logf(1.f + __expf(-sp4[n][j])); }
#pragma unroll
        for (int ai = 0; ai < 2; ++ai) {
            if (ai == 1) {
#pragma unroll
                for (int m = 0; m < 4; ++m) xall[m] = ld_bf8_o(XC, (unsigned)((row0 + 128 + m * 16) * DRNN + ch0));
                __builtin_amdgcn_sched_barrier(0); }
#pragma unroll
            for (int m = 0; m < 4; ++m) { const unsigned o = (unsigned)((row0 + ai * 128 + m * 16) * DRNN + ch0); const u32x4 xw = xall[m];
                u32x4 wl, wu;
#pragma unroll
                for (int n = 0; n < 2; ++n)
#pragma unroll
                    for (int jp = 0; jp < 2; ++jp) { float l2[2], u2[2];
#pragma unroll
                        for (int q = 0; q < 2; ++q) { const int j = jp * 2 + q; const unsigned xwd = xw[2 * n + jp]; const float xv = q ? bfhi(xwd) : bflo(xwd);
                            const float r = __builtin_amdgcn_rcpf(1.f + __builtin_amdgcn_exp2f(fmaf(acc[ai][0][m][n][j], -L2E, ba4[n][j])));
                            const float ig = __builtin_amdgcn_rcpf(1.f + __builtin_amdgcn_exp2f(fmaf(acc[ai][1][m][n][j], -L2E, bx4[n][j])));
                            l2[q] = r * sp4[n][j]; u2[q] = ig * xv; }
                        wl[2 * n + jp] = cvtpk(l2[0], l2[1]); wu[2 * n + jp] = cvtpk(u2[0], u2[1]); }
                *(u32x4*)((char*)LA + (size_t)(o * 2u)) = wl; *(u32x4*)((char*)U + (size_t)(o * 2u)) = wu; }
            __builtin_amdgcn_sched_barrier(0); }
    }
};

struct EpiQKV {
    static constexpr bool PERM = true;
    bf16_t* Q; bf16_t* KB; bf16_t* VB; const float* qg; const float* kg; const float* rope; LAS float* red;
    __device__ __forceinline__ void operator()(const Acc& acc, const Unit& u, int wr, int wc, int fr_, int fq_) const {
        int fr = fr_, fq = fq_; asm volatile("" : "+v"(fr), "+v"(fq));
        const int R0 = u.pm * 256; const bool lat = R0 < NLAT; const int r0 = wr * 64 + fr; const int cw = wc * 32 + 8 * fq;
        const int krow0 = lat ? (R0 >> 12) * SKV + (R0 & 4095) : ((R0 - NLAT) >> 8) * SKV + SEQ;
        if (u.pn == 5) {
#pragma unroll
            for (int ai = 0; ai < 2; ++ai)
#pragma unroll
                for (int m = 0; m < 4; ++m) { bf16_t* vp = VB + (size_t)(krow0 + r0 + ai * 128 + m * 16) * 256 + cw;
#pragma unroll
                    for (int bj = 0; bj < 2; ++bj) st_bf8(vp + bj * 128, acc[ai][bj][m][0], acc[ai][bj][m][1]); }
            return; }
        const int lane = fr | (fq << 4);
#pragma unroll
        for (int ai = 0; ai < 2; ++ai)
#pragma unroll
            for (int m = 0; m < 4; ++m)
#pragma unroll
                for (int bj = 0; bj < 2; ++bj) { float sq = 0.f;
#pragma unroll
                    for (int n = 0; n < 2; ++n) { const f32x4 a = acc[ai][bj][m][n]; sq += a[0] * a[0] + a[1] * a[1] + a[2] * a[2] + a[3] * a[3]; }
                    sq += lane_xor(sq, lane, 16); sq += lane_xor(sq, lane, 32);
                    if (fq == 0) red[((r0 + ai * 128 + m * 16) * 2 + bj) * 4 + wc] = sq; }
        asm volatile("s_waitcnt lgkmcnt(0)" ::: "memory"); __builtin_amdgcn_s_barrier(); asm volatile("" ::: "memory");
        const float* gsel = (u.pn < 4 ? qg : kg) + cw; const f32x4 g4[2] = {*(const f32x4*)gsel, *(const f32x4*)(gsel + 4)};
        const int jb = (wc & 1) * 16 + 4 * fq;
#pragma unroll
        for (int ai = 0; ai < 2; ++ai) {
            f32x4 cs[4][2];
#pragma unroll
            for (int m = 0; m < 4; ++m) { const int t = (R0 + r0 + ai * 128 + m * 16) & 4095; const int pos = (wc < 2) ? (t >> 6) : (t & 63);
#pragma unroll
                for (int n = 0; n < 2; ++n) cs[m][n] = lat ? *(const f32x4*)(rope + (size_t)(pos * 32 + jb + 2 * n) * 2) : (f32x4){1.f, 0.f, 1.f, 0.f}; }
            __builtin_amdgcn_sched_barrier(0);
#pragma unroll
            for (int m = 0; m < 4; ++m) { const int row = r0 + ai * 128 + m * 16;
#pragma unroll
                for (int bj = 0; bj < 2; ++bj) { const f32x4 q = *(const LAS f32x4*)(red + (row * 2 + bj) * 4); const float rs = rsqrtf(((q[0] + q[1]) + (q[2] + q[3])) * (1.f / 128.f) + 1e-6f);
                    f32x4 y[2];
#pragma unroll
                    for (int n = 0; n < 2; ++n) { const f32x4 c4 = cs[m][n]; const f32x4 v = acc[ai][bj][m][n] * rs * g4[n];
                        y[n] = (f32x4){v[0] * c4[0] - v[1] * c4[1], v[0] * c4[1] + v[1] * c4[0], v[2] * c4[2] - v[3] * c4[3], v[2] * c4[3] + v[3] * c4[2]}; }
                    bf16_t* dp = (u.pn < 4) ? Q + (size_t)(R0 + row) * 1024 + u.pn * 256 + bj * 128 + cw : KB + (size_t)(krow0 + row) * 256 + bj * 128 + cw;
                    st_bf8(dp, y[0], y[1]); } }
            __builtin_amdgcn_sched_barrier(0); }
    }
};

template <class Epi, class Order = pg8::StaticOrder>
__device__ __forceinline__ void run_gemm(const int wv, LAS unsigned char* lds, const bf16_t* A, int lda, const bf16_t* Bt, int M, int N, int K, const Epi& E) {
    Order S; S.init(M, N, (int)gridDim.x, (int)blockIdx.x);
    pg8::Gemm g; g.A = A; g.Bt = Bt; g.M = M; g.N = N; g.K = K; g.lda = lda; g.ldb = K;
    pg8::gemm_phase<Epi, Order>(wv, lds, g, S, E);
}

namespace at {
constexpr int D = 128, NW = 8, QBLK = 32, KVBLK = 64;
constexpr float SCALE = 0.088388347648318440f, THR = 8.f;
constexpr int LDQ = 1024, LDK = 256, LDO = 1024;
constexpr size_t SHM_V = KVBLK * D * 2, SHM_K = KVBLK * D * 2;
#define KSWZ(row, colB) ((row) * 256 + ((colB) ^ (((row) & 7) << 4)))
#define SBAR() __builtin_amdgcn_sched_barrier(0)
__device__ __forceinline__ int crow(int r, int hi) { return (r & 3) + 8 * (r >> 2) + 4 * hi; }
__device__ __forceinline__ void partialSM(f32x16& p0, f32x16& p1, float& m_reg, float& mn, float& alpha) {
    constexpr float C = SCALE * 1.4426950408889634f;
    float pmax = p0[0];
#pragma unroll
    for (int r = 1; r < 16; ++r) pmax = fmaxf(pmax, p0[r]);
#pragma unroll
    for (int r = 0; r < 16; ++r) pmax = fmaxf(pmax, p1[r]);
    { auto rr = __builtin_amdgcn_permlane32_swap(__float_as_uint(pmax), __float_as_uint(pmax), false, false);
      pmax = fmaxf(__uint_as_float(rr[0]), __uint_as_float(rr[1])); }
    if (__builtin_expect(__all(pmax - m_reg <= THR / SCALE), 1)) { mn = m_reg; alpha = 1.f; }
    else { mn = fmaxf(m_reg, pmax); alpha = __builtin_amdgcn_exp2f((m_reg - mn) * C); m_reg = mn; }
    float mnC = -mn * C;
#pragma unroll
    for (int r = 0; r < 16; ++r) p0[r] = fmaf(p0[r], C, mnC);
#pragma unroll
    for (int r = 0; r < 16; ++r) p1[r] = fmaf(p1[r], C, mnC);
#pragma unroll
    for (int r = 0; r < 16; ++r) p0[r] = __builtin_amdgcn_exp2f(p0[r]);
}
__device__ __forceinline__ void finishSM(f32x16& p0, f32x16& p1, float alpha, float& l_reg, bf16x8& pa0, bf16x8& pa1, bf16x8& pa2, bf16x8& pa3) {
#pragma unroll
    for (int r = 0; r < 16; ++r) p1[r] = __builtin_amdgcn_exp2f(p1[r]);
    float ps = 0;
#pragma unroll
    for (int r = 0; r < 16; ++r) ps += p0[r];
#pragma unroll
    for (int r = 0; r < 16; ++r) ps += p1[r];
    { auto rr = __builtin_amdgcn_permlane32_swap(__float_as_uint(ps), __float_as_uint(ps), false, false);
      ps = __uint_as_float(rr[0]) + __uint_as_float(rr[1]); }
    l_reg = l_reg * alpha + ps;
#define PK4(P, BASE, OUT) do { unsigned a0 = cvtpk(P[BASE + 0], P[BASE + 1]), a1 = cvtpk(P[BASE + 2], P[BASE + 3]);   \
    unsigned b0 = cvtpk(P[BASE + 4], P[BASE + 5]), b1 = cvtpk(P[BASE + 6], P[BASE + 7]);                              \
    auto r0 = __builtin_amdgcn_permlane32_swap(a0, b0, false, false); auto r1 = __builtin_amdgcn_permlane32_swap(a1, b1, false, false); \
    u32x4 w = {r0[0], r1[0], r0[1], r1[1]}; OUT = *reinterpret_cast<bf16x8*>(&w); } while (0)
    PK4(p0, 0, pa0); PK4(p0, 8, pa1); PK4(p1, 0, pa2); PK4(p1, 8, pa3);
#undef PK4
}
__device__ __forceinline__ void qkt(f32x16& p0, f32x16& p1, const bf16_t* Ks, const bf16x8* qr, int r32, int hi) {
    p0 = f32x16{}; p1 = f32x16{};
#pragma unroll
    for (int d0 = 0; d0 < 8; ++d0) { int cb = (d0 * 16 + hi * 8) * 2;
        bf16x8 b0 = *reinterpret_cast<const bf16x8*>((const char*)Ks + KSWZ(r32, cb));
        bf16x8 b1 = *reinterpret_cast<const bf16x8*>((const char*)Ks + KSWZ(32 + r32, cb));
        p0 = __builtin_amdgcn_mfma_f32_32x32x16_bf16(b0, qr[d0], p0, 0, 0, 0);
        p1 = __builtin_amdgcn_mfma_f32_32x32x16_bf16(b1, qr[d0], p1, 0, 0, 0); }
}
__device__ __forceinline__ int v_st(int k, int c) { const int kk = (k & ~0xC) | ((k & 4) << 1) | ((k & 8) >> 1); return ((kk >> 3) * 4 + (c >> 5)) * 512 + ((kk & 7) * 32 + (c & 31)) * 2; }
__device__ __forceinline__ int v_rd_base(int lane) { return ((lane & 3) << 3) | (((lane >> 2) & 3) << 6) | (((lane >> 4) & 1) << 5) | (((lane >> 5) & 1) << 8); }
constexpr int v_rd_off(int d0, int ks, int half) { return d0 * 512 + ks * 4096 + half * 2048; }
template <int OFF> __device__ __forceinline__ s16x4 tr_read(int vb) {
    s16x4 r; asm volatile("ds_read_b64_tr_b16 %0, %1 offset:%2" : "=&v"(r) : "v"(vb), "i"(OFF) : "memory"); return r;
}
template <int D0> __device__ __forceinline__ void pv_one(f32x16& od, int vb, bf16x8 pa0, bf16x8 pa1, bf16x8 pa2, bf16x8 pa3) {
    const s16x4 l0 = tr_read<v_rd_off(D0, 0, 0)>(vb), h0 = tr_read<v_rd_off(D0, 0, 1)>(vb), l1 = tr_read<v_rd_off(D0, 1, 0)>(vb), h1 = tr_read<v_rd_off(D0, 1, 1)>(vb);
    const s16x4 l2 = tr_read<v_rd_off(D0, 2, 0)>(vb), h2 = tr_read<v_rd_off(D0, 2, 1)>(vb), l3 = tr_read<v_rd_off(D0, 3, 0)>(vb), h3 = tr_read<v_rd_off(D0, 3, 1)>(vb);
    asm volatile("s_waitcnt lgkmcnt(0)" ::: "memory"); SBAR();
#define PK(L, H) (bf16x8){L[0], L[1], L[2], L[3], H[0], H[1], H[2], H[3]}
    od = __builtin_amdgcn_mfma_f32_32x32x16_bf16(pa0, PK(l0, h0), od, 0, 0, 0);
    od = __builtin_amdgcn_mfma_f32_32x32x16_bf16(pa1, PK(l1, h1), od, 0, 0, 0);
    od = __builtin_amdgcn_mfma_f32_32x32x16_bf16(pa2, PK(l2, h2), od, 0, 0, 0);
    od = __builtin_amdgcn_mfma_f32_32x32x16_bf16(pa3, PK(l3, h3), od, 0, 0, 0);
#undef PK
}
__device__ __forceinline__ void pv_d0(f32x16* o, int vb, bf16x8 pa0, bf16x8 pa1, bf16x8 pa2, bf16x8 pa3) {
    pv_one<0>(o[0], vb, pa0, pa1, pa2, pa3); pv_one<1>(o[1], vb, pa0, pa1, pa2, pa3); pv_one<2>(o[2], vb, pa0, pa1, pa2, pa3); pv_one<3>(o[3], vb, pa0, pa1, pa2, pa3);
}
__device__ __forceinline__ void attn_dense_body(const int wv, const bf16_t* __restrict__ Qb, const bf16_t* __restrict__ Kh, const bf16_t* __restrict__ Vh,
                                                bf16_t* __restrict__ Ob, int seq, char* lds) {
    const int tid = ltid(wv), wid = tid >> 6, lane = tid & 63, r32 = lane & 31, hi = lane >> 5;
    bf16_t* V_lds = (bf16_t*)lds; bf16_t* K_lds = (bf16_t*)(lds + 2 * SHM_V);
    float* ws = (float*)(lds + 2 * SHM_V + 2 * SHM_K) + wid * 64; float* li_l = ws; float* al_l = ws + 32;
    float m_reg = -1e30f, l_reg = 0; f32x16 o[4] = {}; bf16x8 qr[8];
    const bf16_t* Qw = Qb + (long)(wid * QBLK + r32) * LDQ + hi * 8;
#pragma unroll
    for (int d0 = 0; d0 < 8; ++d0) qr[d0] = *reinterpret_cast<const bf16x8*>(Qw + d0 * 16);
    const int sr = tid >> 4, sc = (tid & 15) * 8, vst0 = v_st(sr, sc), vst1 = v_st(32 + sr, sc);
    const int vb0 = (int)(uintptr_t)V_lds + v_rd_base(lane);
    struct { bf16x8 vs0, vs1, ks0, ks1; } sr_[2];
#define SLOAD(i, k0) do { sr_[i].vs0 = *reinterpret_cast<const bf16x8*>(&Vh[(long)((k0) + sr) * LDK + sc]); sr_[i].vs1 = *reinterpret_cast<const bf16x8*>(&Vh[(long)((k0) + 32 + sr) * LDK + sc]); \
    sr_[i].ks0 = *reinterpret_cast<const bf16x8*>(&Kh[(long)((k0) + sr) * LDK + sc]); sr_[i].ks1 = *reinterpret_cast<const bf16x8*>(&Kh[(long)((k0) + 32 + sr) * LDK + sc]); } while (0)
#define SWRITE(b, i) do { *(bf16x8*)((char*)V_lds + (b) * SHM_V + vst0) = sr_[i].vs0;          \
    *(bf16x8*)((char*)V_lds + (b) * SHM_V + vst1) = sr_[i].vs1; int kc = sc * 2;               \
    *(bf16x8*)((char*)K_lds + (b) * SHM_K + KSWZ(sr, kc)) = sr_[i].ks0;                       \
    *(bf16x8*)((char*)K_lds + (b) * SHM_K + KSWZ(32 + sr, kc)) = sr_[i].ks1; } while (0)
#define SWAIT() asm volatile("s_waitcnt vmcnt(4)" ::: "memory")
#define RESC(a) do { if (__any((a) < 1.f)) { if (hi == 0) al_l[r32] = (a); asm volatile("s_waitcnt lgkmcnt(0)" ::: "memory"); \
    _Pragma("unroll") for (int d = 0; d < 4; ++d) _Pragma("unroll") for (int r = 0; r < 16; ++r) o[d][r] *= al_l[crow(r, hi)]; } } while (0)
    f32x16 pA0, pA1, pB0, pB1; float mnA, mnB, alA, alB; bf16x8 pa0, pa1, pa2, pa3; const int NT = seq / KVBLK;
    constexpr int SE = 0, SO = 1;
    SLOAD(SE, 0); asm volatile("s_waitcnt vmcnt(0)" ::: "memory"); SWRITE(0, SE); __syncthreads();
    qkt(pA0, pA1, K_lds, qr, r32, hi); partialSM(pA0, pA1, m_reg, mnA, alA);
    SLOAD(SO, KVBLK); if (2 < NT) SLOAD(SE, 2 * KVBLK);
    SWAIT(); SWRITE(1, SO); __syncthreads();
    for (int j = 1; j + 1 < NT; j += 2) {
        SBAR(); qkt(pB0, pB1, (bf16_t*)((char*)K_lds + SHM_K), qr, r32, hi);
        finishSM(pA0, pA1, alA, l_reg, pa0, pa1, pa2, pa3); SBAR();
        SLOAD(SO, (j + 2) * KVBLK); SBAR();
        pv_d0(o, vb0, pa0, pa1, pa2, pa3); partialSM(pB0, pB1, m_reg, mnB, alB);
        __syncthreads(); SWAIT(); SWRITE(0, SE);
        RESC(alB); __syncthreads();
        SBAR(); qkt(pA0, pA1, K_lds, qr, r32, hi);
        finishSM(pB0, pB1, alB, l_reg, pa0, pa1, pa2, pa3); SBAR();
        if (j + 3 < NT) SLOAD(SE, (j + 3) * KVBLK); SBAR();
        pv_d0(o, vb0 + (int)SHM_V, pa0, pa1, pa2, pa3); partialSM(pA0, pA1, m_reg, mnA, alA);
        __syncthreads(); SWAIT(); SWRITE(1, SO);
        RESC(alA); __syncthreads();
    }
    SBAR(); qkt(pB0, pB1, (bf16_t*)((char*)K_lds + SHM_K), qr, r32, hi);
    finishSM(pA0, pA1, alA, l_reg, pa0, pa1, pa2, pa3); SBAR();
    pv_d0(o, vb0, pa0, pa1, pa2, pa3); partialSM(pB0, pB1, m_reg, mnB, alB);
    __syncthreads(); RESC(alB);
    finishSM(pB0, pB1, alB, l_reg, pa0, pa1, pa2, pa3); SBAR();
    pv_d0(o, vb0 + (int)SHM_V, pa0, pa1, pa2, pa3);
    if (hi == 0) li_l[r32] = l_reg; asm volatile("s_waitcnt lgkmcnt(0)" ::: "memory");
    float rli[16];
#pragma unroll
    for (int r = 0; r < 16; ++r) rli[r] = __builtin_amdgcn_rcpf(li_l[crow(r, hi)]);
    bf16_t* Ow = Ob + (long)(wid * QBLK) * LDO;
#pragma unroll
    for (int r = 0; r < 16; ++r) { int orow = crow(r, hi);
#pragma unroll
        for (int d0 = 0; d0 < 4; ++d0) Ow[(long)orow * LDO + d0 * 32 + r32] = f2bf(o[d0][r] * rli[r]); }
#undef SLOAD
#undef SWRITE
#undef SWAIT
#undef RESC
}
}

template <bool FW = false>
__device__ __forceinline__ void tr_job(const int wv, const float* __restrict__ src, bf16_t* __restrict__ dst, int K, int N, float* t, int& off) {
    const int G = gridDim.x, tid = ltid(wv); const int tn = N / 64, ntiles = (K / 64) * tn;
    int first = ((int)blockIdx.x - (off % G) + G) % G;
    for (int tile = first; tile < ntiles; tile += G) {
        const int k0 = (tile / tn) * 64, n0 = (tile % tn) * 64;
        { const int kk = tid >> 4, c4 = (tid & 15) * 4;
#pragma unroll
          for (int h = 0; h < 2; ++h) { f32x4 v;
              if (!FW) v = *(const f32x4*)(src + (size_t)(k0 + kk + h * 32) * N + n0 + c4);
              else { const int n = k0 + kk + h * 32; int r1, r2; float s2 = 1.f;
                  if (n < 512) { const int g = n >> 6, l = n & 63; r1 = g * 128 + l; r2 = l ? g * 128 + 128 - l : -1; }
                  else if (n < 520) { r1 = (n - 512) * 128 + 64; r2 = -1; }
                  else { const int q = n - 520; const int g = q / 63, l = q - g * 63 + 1; r1 = g * 128 + 128 - l; r2 = g * 128 + l; s2 = -1.f; }
                  v = *(const f32x4*)(src + (size_t)r1 * N + n0 + c4);
                  if (r2 >= 0) v += *(const f32x4*)(src + (size_t)r2 * N + n0 + c4) * s2; }
              float* tp = t + (kk + h * 32) * 65 + c4; tp[0] = v[0]; tp[1] = v[1]; tp[2] = v[2]; tp[3] = v[3]; } }
        __syncthreads();
        { const int nn = tid >> 3, kc = (tid & 7) * 8; float v[8];
#pragma unroll
          for (int j = 0; j < 8; ++j) v[j] = t[(kc + j) * 65 + nn];
          u32x4 w = {cvtpk(v[0], v[1]), cvtpk(v[2], v[3]), cvtpk(v[4], v[5]), cvtpk(v[6], v[7])};
          *(u32x4*)(dst + (size_t)(n0 + nn) * K + k0 + kc) = w; }
        __syncthreads();
    }
    off += ntiles;
}

typedef const __attribute__((address_space(4))) Params* PP;
__device__ __forceinline__ void prep_phase(const int wv, PP p, char* lds) {
    const int tid = ltid(wv), lane = tid & 63, wid = tid >> 6, G = gridDim.x, bid = blockIdx.x;
    unsigned char* ws = p->ws;
    {
        float* sT = (float*)lds; float* red = (float*)(lds + 81920);
        for (int idx = tid; idx < 20 * 1024; idx += 512) { const int r = idx >> 10, k = idx & 1023; float v = 0.f;
            if (r < 17) { const float cv = r < 16 ? p->c[r * 1024 + k] : p->c_ctx[k]; v = cv / (1.f + __expf(-cv)); }
            sT[k * 20 + r] = v; }
        __syncthreads();
        for (int task = bid; task < 192; task += G) {
            const int layer = task / 48, chunk = task % 48; const int colw = tid & 127, kg = tid >> 7, n = chunk * 128 + colw;
            float acc[17];
#pragma unroll
            for (int r = 0; r < 17; ++r) acc[r] = 0.f;
            const float* wp = p->ada_w + ((size_t)layer * 1024 + kg * 256) * 6144 + n;
#pragma unroll 16
            for (int k = 0; k < 256; ++k) { const float w = wp[(size_t)k * 6144]; const float* sp = sT + (kg * 256 + k) * 20;
                const f32x4 s0 = *(const f32x4*)sp, s1 = *(const f32x4*)(sp + 4), s2 = *(const f32x4*)(sp + 8), s3 = *(const f32x4*)(sp + 12); const float s16 = sp[16];
#pragma unroll
                for (int j = 0; j < 4; ++j) { acc[j] += s0[j] * w; acc[4 + j] += s1[j] * w; acc[8 + j] += s2[j] * w; acc[12 + j] += s3[j] * w; }
                acc[16] += s16 * w; }
#pragma unroll
            for (int r = 0; r < 17; ++r) red[(kg * 17 + r) * 128 + colw] = acc[r];
            __syncthreads();
            for (int idx = tid; idx < 17 * 128; idx += 512) { const int r = idx >> 7, cw = idx & 127; const int nn = chunk * 128 + cw;
                const float s = red[(0 * 17 + r) * 128 + cw] + red[(1 * 17 + r) * 128 + cw] + red[(2 * 17 + r) * 128 + cw] + red[(3 * 17 + r) * 128 + cw] + p->ada_b[layer * 6144 + nn];
                ((float*)(ws + O_MOD))[((size_t)layer * 17 + r) * 6144 + nn] = s; }
            __syncthreads();
        }
        __syncthreads();
    }
    {
        float* t = (float*)lds; int off = 0;
        for (int l = 0; l < 4; ++l) {
            tr_job(wv, p->mlp_w1 + (size_t)l * 1024 * 4096, (bf16_t*)(ws + O_W1T) + (size_t)l * 4096 * 1024, 1024, 4096, t, off);
            tr_job(wv, p->mlp_w2 + (size_t)l * 4096 * 1024, (bf16_t*)(ws + O_W2T) + (size_t)l * 1024 * 4096, 4096, 1024, t, off);
        }
        for (int j = 0; j < 2; ++j) tr_job<true>(wv, p->fnet_w_out + (size_t)j * 1024 * 1024, (bf16_t*)(ws + O_FWOT) + (size_t)j * 1024 * 1024, 1024, 1024, t, off);
        tr_job(wv, p->attn_w_qkv, (bf16_t*)(ws + O_WQKVT), 1024, 1536, t, off);
        tr_job(wv, p->attn_w_o, (bf16_t*)(ws + O_WOT), 1024, 1024, t, off);
        tr_job(wv, p->lru_w_in, (bf16_t*)(ws + O_LWINT), 1024, 2560, t, off);
        tr_job(wv, p->lru_w_out, (bf16_t*)(ws + O_LWOT), 1280, 1024, t, off);
    }
    {
        float* wt = (float*)lds; float* tab = (float*)(lds + 64 * 129 * 4);
        for (int task = bid; task < 256; task += G) {
            const int j = task >> 7, g = (task >> 4) & 7, k0 = (task & 15) * 64;
            if (tid < 128) tab[tid] = cospif((float)tid * (1.f / 64.f));
#pragma unroll
            for (int i = 0; i < 4; ++i) { const int idx = tid + i * 512; const int row = idx >> 5, c4 = (idx & 31) * 4;
                const f32x4 v = *(const f32x4*)(p->fnet_w_in + ((size_t)j * 1024 + k0 + row) * 1024 + g * 128 + c4); float* tp = wt + row * 129 + c4; tp[0] = v[0]; tp[1] = v[1]; tp[2] = v[2]; tp[3] = v[3]; }
            __syncthreads();
            bf16_t* dstb = (bf16_t*)(ws + O_WPQT) + (size_t)j * 1024 * 1024;
            for (int ii = 0; ii < 16; ++ii) { const int i = wid * 16 + ii; const int sf = i > 64 ? 1 : 0; const int l = sf ? i - 64 : i;
                const int n = sf ? 520 + g * 63 + l - 1 : (l < 64 ? g * 64 + l : 512 + g);
                float acc = 0.f; const float* wr_ = wt + lane * 129;
#pragma unroll 8
                for (int c = 0; c < 128; ++c) acc += wr_[c] * tab[(l * c - sf * 32) & 127];
                dstb[(size_t)n * 1024 + k0 + lane] = f2bf(acc); }
            __syncthreads();
        }
    }
    { float* rt = (float*)(ws + O_ROPE); for (int i = bid * 512 + tid; i < 2048; i += G * 512) { const int pos = i >> 5, j = i & 31; const float inv = powf(10000.f, -(float)j * (1.f / 32.f)); float sn, cs; sincosf((float)pos * inv, &sn, &cs); rt[i * 2] = cs; rt[i * 2 + 1] = sn; } }
    {
        bf16_t* gt = (bf16_t*)(ws + O_GATET);
        for (int idx = bid * 512 + tid; idx < 2 * 2560 * 256; idx += G * 512) {
            const int d = idx / (2560 * 256); const int rem = idx - d * 2560 * 256; const int n = rem >> 8, k = rem & 255;
            const int blk = n >> 8, half = (n >> 7) & 1, jout = n & 127, kq = k >> 7, i = k & 127; float v = 0.f;
            if (kq == (blk & 1)) v = (half ? p->gx_w : p->ga_w)[(((size_t)d * 10 + blk) * 128 + i) * 128 + jout];
            gt[idx] = f2bf(v); }
    }
    {
        bf16_t* d2 = (bf16_t*)(ws + O_D256);
        for (int idx = bid * 512 + tid; idx < 512 * 256; idx += G * 512) { const int r = idx >> 8, t = idx & 255; const float a = (float)(((r & 255) * t) & 255) * (1.f / 128.f);
            d2[idx] = f2bf(r < 256 ? cospif(a) : sinpif(a)); }
    }
}

__device__ __forceinline__ void dmat_gen(const int wv, bf16_t* dm, char* lds) {
    float* tab = (float*)lds; const int tid = ltid(wv);
    for (int i = tid; i < 4096; i += 512) tab[i] = cospif((float)i * (1.f / 2048.f));
    __syncthreads();
    constexpr int VR = KF / 8;
    for (int idx = blockIdx.x * 512 + tid; idx < 4096 * VR; idx += gridDim.x * 512) { const int row = idx / VR, v = idx - row * VR; const int type = row >> 11, cls = (row >> 10) & 1, k = 2 * (row & 1023) + cls; const int t0 = v * 8; const int sh = type ? 3072 : 0;
        float f[8];
#pragma unroll
        for (int e = 0; e < 8; ++e) f[e] = (t0 + e <= 1024) ? tab[(k * (t0 + e) + sh) & 4095] : 0.f;
        u32x4 w = {cvtpk(f[0], f[1]), cvtpk(f[2], f[3]), cvtpk(f[4], f[5]), cvtpk(f[6], f[7])};
        *(u32x4*)(dm + (size_t)idx * 8) = w; }
    __syncthreads();
}
__device__ __forceinline__ void fold_phase(const int wv, const bf16_t* __restrict__ src, bf16_t* __restrict__ dst) {
    const int tid = ltid(wv); const int lane = tid & 63, wid = tid >> 6; const int gwv = blockIdx.x * 8 + wid, nwv = gridDim.x * 8;
    for (int r = gwv; r < 16640; r += nwv) { const bf16_t* rp = src + (size_t)r * 4096; bf16_t* wE = dst + (size_t)r * KF; bf16_t* wO = dst + (size_t)(16640 + r) * KF;
        const bool isq = (r >= 8192 && r < 16384); const float sg = isq ? -1.f : 1.f;
        u32x4 a1[2], a2[2], g1[2], h1[2]; bf16_t gx[2], hx[2];
#pragma unroll
        for (int i = 0; i < 2; ++i) { const int t0 = i * 512 + lane * 8; a1[i] = *(const u32x4*)(rp + t0); a2[i] = *(const u32x4*)(rp + 2048 + t0); g1[i] = *(const u32x4*)(rp + 2040 - t0); h1[i] = *(const u32x4*)(rp + 4088 - t0);
            gx[i] = rp[2048 - t0]; hx[i] = rp[t0 ? 4096 - t0 : 0]; }
        const float x1024 = bf1(rp[1024]) + sg * bf1(rp[3072]);
#pragma unroll
        for (int i = 0; i < 2; ++i) { const int t0 = i * 512 + lane * 8;
#define UNPK(W) {bflo(W[0]), bfhi(W[0]), bflo(W[1]), bfhi(W[1]), bflo(W[2]), bfhi(W[2]), bflo(W[3]), bfhi(W[3])}
            const float xa[8] = UNPK(a1[i]); const float xb2[8] = UNPK(a2[i]); const float yg[8] = UNPK(g1[i]); const float yh[8] = UNPK(h1[i]);
#undef UNPK
            float oe[8], oo[8];
#pragma unroll
            for (int e = 0; e < 8; ++e) { const bool t_is0 = (e == 0) && (t0 == 0);
                const float p_t = xa[e], p_2048pt = t_is0 ? 0.f : xb2[e];
                const float p_2048mt = e ? yg[8 - e] : bf1(gx[i]);
                const float p_4096mt = t_is0 ? 0.f : (e ? yh[8 - e] : bf1(hx[i]));
                const float s1 = p_t + sg * p_4096mt, s2 = p_2048mt + sg * p_2048pt;
                oe[e] = s1 + sg * s2; oo[e] = s1 - sg * s2; }
            const u32x4 we = {cvtpk(oe[0], oe[1]), cvtpk(oe[2], oe[3]), cvtpk(oe[4], oe[5]), cvtpk(oe[6], oe[7])};
            const u32x4 wo = {cvtpk(oo[0], oo[1]), cvtpk(oo[2], oo[3]), cvtpk(oo[4], oo[5]), cvtpk(oo[6], oo[7])};
            *(u32x4*)(wE + t0) = we; *(u32x4*)(wO + t0) = wo; }
        const unsigned x16 = cvtpk(x1024, 0.f) & 0xffffu;
        *(unsigned*)(wE + 1024 + lane * 2) = (lane == 0 && !isq) ? x16 : 0u;
        *(unsigned*)(wO + 1024 + lane * 2) = (lane == 0 && isq) ? x16 : 0u;
    }
}
__device__ __forceinline__ void nyquist_pass(const int wv, const bf16_t* PP, const bf16_t* P64, bf16_t* F, float scale) {
    const int tid = ltid(wv); const int lane = tid & 63, wid = tid >> 6; const int gwv = blockIdx.x * 8 + wid, nwv = gridDim.x * 8;
    for (int r = gwv; r < 8192 + 128; r += nwv) { const bf16_t* src; int b, n;
        if (r < 8192) { src = PP + (size_t)r * 4096; b = r >> 9; n = r & 511; } else { const int rr = r - 8192; src = P64 + (size_t)rr * 4096; b = rr >> 3; n = 512 + (rr & 7); }
        float sacc = 0.f;
#pragma unroll
        for (int i = 0; i < 8; ++i) { const u32x4 w = *(const u32x4*)(src + i * 512 + lane * 8);
            sacc += (bflo(w[0]) - bfhi(w[0])) + (bflo(w[1]) - bfhi(w[1])) + (bflo(w[2]) - bfhi(w[2])) + (bflo(w[3]) - bfhi(w[3])); }
        sacc = wave_sum(sacc, lane);
        if (lane == 0) F[((size_t)b * 4096 + 2048) * 1024 + n] = f2bf(sacc * scale); }
    for (int idx = blockIdx.x * 512 + tid; idx < 16 * 504; idx += gridDim.x * 512) { const int b = idx / 504, q = idx - b * 504; F[((size_t)b * 4096 + 2048) * 1024 + 520 + q] = 0; }
}

template <bool F32IN>
__device__ __forceinline__ void norm_phase(const int wv, const float* __restrict__ xl, const float* __restrict__ xc, bf16_t* xb, const float* __restrict__ gw, const float* __restrict__ mod, int shoff, int scoff, bf16_t* __restrict__ H, int nrows,
                                           const float* __restrict__ part = nullptr, const float* __restrict__ pgate = nullptr) {
    const int tid = ltid(wv); const int lane = tid & 63, wid = tid >> 6; const int gwv = blockIdx.x * 8 + wid, nwv = gridDim.x * 8; const int ntask = nrows / 8;
    for (int task = gwv; task < ntask; task += nwv) {
        const int row0 = task * 8; const int bidx = row0 < NLAT ? (row0 >> 12) : 16; const float* mrow = mod + bidx * 6144;
        const float* src0 = (row0 < NLAT ? xl + (size_t)row0 * 1024 : xc + (size_t)(row0 - NLAT) * 1024) + lane * 4;
        bf16_t* xr0 = xb + (size_t)row0 * 1024 + lane * 4;
        f32x4 mul[4], add[4];
#pragma unroll
        for (int j = 0; j < 4; ++j) { const int col = j * 256 + lane * 4; const f32x4 g4 = *(const f32x4*)(gw + col), sc4 = *(const f32x4*)(mrow + scoff + col); add[j] = *(const f32x4*)(mrow + shoff + col); mul[j] = g4 * (sc4 + 1.f); }
#pragma unroll
        for (int hb = 0; hb < 2; ++hb) {
            f32x4 v[4][4];
            if (F32IN) {
#pragma unroll
                for (int r = 0; r < 4; ++r)
#pragma unroll
                    for (int j = 0; j < 4; ++j) v[r][j] = *(const f32x4*)(src0 + (size_t)(hb * 4 + r) * 1024 + j * 256);
                __builtin_amdgcn_sched_barrier(0);
#pragma unroll
                for (int r = 0; r < 4; ++r)
#pragma unroll
                    for (int j = 0; j < 4; ++j) st_bf4(xr0 + (size_t)(hb * 4 + r) * 1024 + j * 256, v[r][j]);
            } else {
                u32x2 w[4][4];
#pragma unroll
                for (int r = 0; r < 4; ++r)
#pragma unroll
                    for (int j = 0; j < 4; ++j) w[r][j] = *(const u32x2*)(xr0 + (size_t)(hb * 4 + r) * 1024 + j * 256);
                __builtin_amdgcn_sched_barrier(0);
#pragma unroll
                for (int r = 0; r < 4; ++r)
#pragma unroll
                    for (int j = 0; j < 4; ++j) v[r][j] = (f32x4){bflo(w[r][j][0]), bfhi(w[r][j][0]), bflo(w[r][j][1]), bfhi(w[r][j][1])};
            }
            if (part && row0 >= NLAT) {
#pragma unroll
                for (int r = 0; r < 4; ++r) { const size_t o = (size_t)(row0 - NLAT + hb * 4 + r) * 1024 + lane * 4;
#pragma unroll
                    for (int j = 0; j < 4; ++j) { const f32x4 g4 = *(const f32x4*)(pgate + j * 256 + lane * 4);
                        const f32x4 p0 = *(const f32x4*)(part + o + j * 256), p1 = *(const f32x4*)(part + (size_t)NCTX * 1024 + o + j * 256), p2 = *(const f32x4*)(part + (size_t)2 * NCTX * 1024 + o + j * 256), p3 = *(const f32x4*)(part + (size_t)3 * NCTX * 1024 + o + j * 256);
                        v[r][j] += g4 * ((p0 + p1) + (p2 + p3)); st_bf4(xr0 + (size_t)(hb * 4 + r) * 1024 + j * 256, v[r][j]); } }
                __builtin_amdgcn_sched_barrier(0); }
#pragma unroll
            for (int r = 0; r < 4; ++r) { float ss = 0.f;
#pragma unroll
                for (int j = 0; j < 4; ++j) ss += v[r][j][0] * v[r][j][0] + v[r][j][1] * v[r][j][1] + v[r][j][2] * v[r][j][2] + v[r][j][3] * v[r][j][3];
                ss = wave_sum(ss, lane); const float rstd = rsqrtf(ss * (1.f / 1024.f) + 1e-6f);
#pragma unroll
                for (int j = 0; j < 4; ++j) st_bf4(H + (size_t)(row0 + hb * 4 + r) * 1024 + j * 256 + lane * 4, v[r][j] * rstd * mul[j] + add[j]); }
            __builtin_amdgcn_sched_barrier(0);
        }
    }
}

__device__ __forceinline__ void final_phase(const int wv, const bf16_t* __restrict__ xb, float* __restrict__ out, const float* __restrict__ gw) {
    const int tid = ltid(wv); const int lane = tid & 63, wid = tid >> 6; const int gwv = blockIdx.x * 8 + wid, nwv = gridDim.x * 8;
    f32x4 g4[4];
#pragma unroll
    for (int j = 0; j < 4; ++j) g4[j] = *(const f32x4*)(gw + j * 256 + lane * 4);
    for (int task = gwv; task < NLAT / 4; task += nwv) { const bf16_t* src = xb + (size_t)task * 4 * 1024 + lane * 4; float* dst = out + (size_t)task * 4 * 1024 + lane * 4; u32x2 w[4][4];
#pragma unroll
        for (int r = 0; r < 4; ++r)
#pragma unroll
            for (int j = 0; j < 4; ++j) w[r][j] = *(const u32x2*)(src + (size_t)r * 1024 + j * 256);
        __builtin_amdgcn_sched_barrier(0);
#pragma unroll
        for (int r = 0; r < 4; ++r) { f32x4 v[4]; float ss = 0.f;
#pragma unroll
            for (int j = 0; j < 4; ++j) { v[j] = (f32x4){bflo(w[r][j][0]), bfhi(w[r][j][0]), bflo(w[r][j][1]), bfhi(w[r][j][1])}; ss += v[j][0] * v[j][0] + v[j][1] * v[j][1] + v[j][2] * v[j][2] + v[j][3] * v[j][3]; }
            ss = wave_sum(ss, lane); const float rstd = rsqrtf(ss * (1.f / 1024.f) + 1e-6f);
#pragma unroll
            for (int j = 0; j < 4; ++j) *(f32x4*)(dst + (size_t)r * 1024 + j * 256) = v[j] * rstd * g4[j]; }
        __builtin_amdgcn_sched_barrier(0); }
}

__device__ __forceinline__ void qknorm_phase(const int wv, const bf16_t* raw, bf16_t* Q, bf16_t* KB, bf16_t* VB, const float* qg, const float* kg, char* lds) {
    float* ctab = (float*)lds; float* stab = ctab + 2048; const int tid = ltid(wv), lane = tid & 63, wid = tid >> 6;
    for (int i = tid; i < 2048; i += 512) { const int pos = i >> 5, j = i & 31; const float inv = powf(10000.f, -(float)j * (1.f / 32.f)); const float ang = (float)pos * inv; float s, c; sincosf(ang, &s, &c); ctab[i] = c; stab[i] = s; }
    __syncthreads();
    const int gwv = blockIdx.x * 8 + wid, nwv = gridDim.x * 8; const int l16 = lane & 15; const int nwt = NTOK * 12 / 4;
    for (int wt0 = gwv * 4; wt0 < nwt; wt0 += nwv * 4) {
        u32x4 wv[4];
#pragma unroll
        for (int q = 0; q < 4; ++q) { const int tk = (wt0 + q) * 4 + (lane >> 4); const int row = tk / 12, hs = tk - row * 12; wv[q] = *(const u32x4*)(raw + (size_t)row * 1536 + hs * 128 + l16 * 8); }
        __builtin_amdgcn_sched_barrier(0);
#pragma unroll
        for (int q = 0; q < 4; ++q) {
            const int tk = (wt0 + q) * 4 + (lane >> 4); const int row = tk / 12, hs = tk - row * 12; const u32x4 w = wv[q];
            float y[8] = {bflo(w[0]), bfhi(w[0]), bflo(w[1]), bfhi(w[1]), bflo(w[2]), bfhi(w[2]), bflo(w[3]), bfhi(w[3])};
            float ss = 0.f;
#pragma unroll
            for (int e = 0; e < 8; ++e) ss += y[e] * y[e];
            ss += lane_xor(ss, lane, 1); ss += lane_xor(ss, lane, 2); ss += lane_xor(ss, lane, 4); ss += lane_xor(ss, lane, 8);
            int krow;
            if (row < NLAT) krow = (row >> 12) * SKV + (row & 4095); else { const int rc = row - NLAT; krow = (rc >> 8) * SKV + SEQ + (rc & 255); }
            if (hs < 10) {
                const float rstd = rsqrtf(ss * (1.f / 128.f) + 1e-6f); const float* gp = (hs < 8 ? qg : kg) + l16 * 8;
#pragma unroll
                for (int e = 0; e < 8; ++e) y[e] = y[e] * rstd * gp[e];
                if (row < NLAT) { const int t = row & 4095, ri = t >> 6, ci = t & 63;
#pragma unroll
                    for (int pp = 0; pp < 4; ++pp) { const int i = l16 * 4 + pp; const int pos = i < 32 ? ri : ci; const int j = i & 31; const float cs = ctab[pos * 32 + j], sn = stab[pos * 32 + j];
                        const float y0 = y[2 * pp], y1 = y[2 * pp + 1]; y[2 * pp] = y0 * cs - y1 * sn; y[2 * pp + 1] = y0 * sn + y1 * cs; } }
                const u32x4 o = {cvtpk(y[0], y[1]), cvtpk(y[2], y[3]), cvtpk(y[4], y[5]), cvtpk(y[6], y[7])};
                if (hs < 8) *(u32x4*)(Q + (size_t)row * 1024 + hs * 128 + l16 * 8) = o;
                else *(u32x4*)(KB + (size_t)krow * 256 + (hs - 8) * 128 + l16 * 8) = o;
            } else *(u32x4*)(VB + (size_t)krow * 256 + (hs - 10) * 128 + l16 * 8) = w;
        }
        __builtin_amdgcn_sched_barrier(0);
    }
    __syncthreads();
}

__device__ __forceinline__ void attn_phase(const int wv, const bf16_t* Q, const bf16_t* KB, const bf16_t* VB, bf16_t* O, char* lds) {
    const int G = gridDim.x;
    for (int u = blockIdx.x; u < 2048 + 128; u += G) {
        if (u < 2048) {
            int qb, gh;
            if (G == 256) { const int w = u & 255, rnd = u >> 8; const int xcd = w & 7, slot = w >> 3; gh = rnd * 16 + 2 * xcd + (slot >> 4); qb = slot & 15; }
            else { qb = u & 15; gh = u >> 4; }
            const int h = gh & 7, b = gh >> 3; const int kvh = h >> 2;
            const size_t q0 = ((size_t)b * SEQ + qb * 256) * 1024 + h * 128; const size_t k0 = (size_t)b * SKV * 256 + kvh * 128;
            at::attn_dense_body(wv, Q + q0, KB + k0, VB + k0, O + q0, SKV, lds);
        } else { const int v = u - 2048; const int h = v & 7, b = v >> 3; const int kvh = h >> 2;
            const size_t q0 = ((size_t)NLAT + b * 256) * 1024 + h * 128; const size_t k0 = ((size_t)b * SKV + SEQ) * 256 + kvh * 128;
            at::attn_dense_body(wv, Q + q0, KB + k0, VB + k0, O + q0, TCTX, lds); }
        __syncthreads();
    }
}

__device__ __forceinline__ void conv_phase(const int wv, const bf16_t* __restrict__ XR, bf16_t* __restrict__ XC, const float* __restrict__ cw, const float* __restrict__ cb) {
    const int total = (NTOK / 8) * 160; const int tid_ = ltid(wv);
    for (int idx = blockIdx.x * 512 + tid_; idx < total; idx += gridDim.x * 512) {
        const int rb = idx / 160, v = idx - rb * 160, ch0 = v * 8, row0 = rb * 8; int t0, T;
        if (row0 < NLAT) { t0 = row0 & 4095; T = SEQ; } else { t0 = (row0 - NLAT) & 255; T = TCTX; }
        u32x4 xw[11];
#pragma unroll
        for (int i = 0; i < 11; ++i) { const int tt = t0 + i - 2; xw[i] = (tt >= 0 && tt < T) ? *(const u32x4*)(XR + (size_t)(row0 + i - 2) * DRNN + ch0) : (u32x4){0u, 0u, 0u, 0u}; }
        f32x4 wk[4][2], bb[2];
#pragma unroll
        for (int k = 0; k < 4; ++k) { wk[k][0] = *(const f32x4*)(cw + k * DRNN + ch0); wk[k][1] = *(const f32x4*)(cw + k * DRNN + ch0 + 4); }
        bb[0] = *(const f32x4*)(cb + ch0); bb[1] = *(const f32x4*)(cb + ch0 + 4);
        __builtin_amdgcn_sched_barrier(0);
#pragma unroll
        for (int r = 0; r < 8; ++r) { f32x4 a0 = bb[0], a1 = bb[1];
#pragma unroll
            for (int k = 0; k < 4; ++k) { const u32x4 w = xw[r + k];
                a0 += wk[k][0] * (f32x4){bflo(w[0]), bfhi(w[0]), bflo(w[1]), bfhi(w[1])}; a1 += wk[k][1] * (f32x4){bflo(w[2]), bfhi(w[2]), bflo(w[3]), bfhi(w[3])}; }
            const u32x4 o = {cvtpk(a0[0], a0[1]), cvtpk(a0[2], a0[3]), cvtpk(a1[0], a1[1]), cvtpk(a1[2], a1[3])};
            *(u32x4*)(XC + (size_t)(row0 + r) * DRNN + ch0) = o; }
    }
}

__device__ __forceinline__ void scan_phase(const int wv, int dir, const bf16_t* LA, const bf16_t* U, bf16_t* R, bf16_t* Gb, char* lds) {
    float* sA = (float*)lds; float* sH = sA + 512; const int tid = ltid(wv), lane = tid & 63, wid = tid >> 6;
    constexpr int CH = SKV / 8;
    for (int task = blockIdx.x; task < NBATCH * 20; task += gridDim.x) {
        const int b = task / 20, cgp = task - b * 20; const int ch = cgp * 64 + lane;
        const int s_begin = wid * CH;
        float sumla = 0.f, hh = 0.f;
        for (int s0 = s_begin; s0 < s_begin + CH; s0 += 16) {
            long row0; int st;
            if (dir == 0) { st = 1; row0 = s0 < TCTX ? (long)NLAT + b * TCTX + s0 : (long)b * SEQ + (s0 - TCTX); }
            else { st = -1; row0 = s0 < TCTX ? (long)NLAT + b * TCTX + (TCTX - 1 - s0) : (long)b * SEQ + (SEQ - 1 - (s0 - TCTX)); }
            bf16_t la[16], uu[16];
#pragma unroll
            for (int k = 0; k < 16; ++k) { const size_t o = (size_t)(row0 + (long)st * k) * DRNN + ch; la[k] = LA[o]; uu[k] = U[o]; }
#pragma unroll
            for (int k = 0; k < 16; ++k) { const float l = bf1(la[k]); const float a = __builtin_amdgcn_exp2f(l * 1.4426950408889634f); hh = a * hh + __builtin_amdgcn_sqrtf(fmaxf(1.f - a * a, 0.f)) * bf1(uu[k]); sumla += l; }
        }
        sA[wid * 64 + lane] = sumla; sH[wid * 64 + lane] = hh;
        __syncthreads();
        float h = 0.f;
        for (int w2 = 0; w2 < wid; ++w2) h = __expf(sA[w2 * 64 + lane]) * h + sH[w2 * 64 + lane];
        for (int s0 = s_begin; s0 < s_begin + CH; s0 += 16) {
            long row0; int st;
            if (dir == 0) { st = 1; row0 = s0 < TCTX ? (long)NLAT + b * TCTX + s0 : (long)b * SEQ + (s0 - TCTX); }
            else { st = -1; row0 = s0 < TCTX ? (long)NLAT + b * TCTX + (TCTX - 1 - s0) : (long)b * SEQ + (SEQ - 1 - (s0 - TCTX)); }
            bf16_t la[16], uu[16], ex[16];
#pragma unroll
            for (int k = 0; k < 16; ++k) { const size_t o = (size_t)(row0 + (long)st * k) * DRNN + ch; la[k] = LA[o]; uu[k] = U[o]; }
            if (dir == 1) {
#pragma unroll
                for (int k = 0; k < 16; ++k) { const size_t o = (size_t)(row0 + (long)st * k) * DRNN + ch; ex[k] = R[o]; la[k] = la[k]; }
            }
            bf16_t gg[16];
            if (dir == 1) {
#pragma unroll
                for (int k = 0; k < 16; ++k) { const size_t o = (size_t)(row0 + (long)st * k) * DRNN + ch; gg[k] = Gb[o]; }
            }
#pragma unroll
            for (int k = 0; k < 16; ++k) { const size_t o = (size_t)(row0 + (long)st * k) * DRNN + ch; { const float a = __builtin_amdgcn_exp2f(bf1(la[k]) * 1.4426950408889634f); h = a * h + __builtin_amdgcn_sqrtf(fmaxf(1.f - a * a, 0.f)) * bf1(uu[k]); }
                if (dir == 0) R[o] = f2bf(h); else Gb[o] = f2bf(bf1(gg[k]) * (bf1(ex[k]) + h)); }
        }
        __syncthreads();
    }
}

__global__ __launch_bounds__(512, 2) void mk(Params p_unused, int ph0, int ph1) {
    extern __shared__ __attribute__((aligned(16))) unsigned char shm[];
    LAS unsigned char* lds3 = (LAS unsigned char*)shm; char* lds = (char*)shm;
    int wv = __builtin_amdgcn_readfirstlane((int)(threadIdx.x >> 6)); asm volatile("" : "+s"(wv));
    volatile LAS unsigned* bst = (volatile LAS unsigned*)(lds3 + 131072 + 2048);
    if (ph1 - ph0 > 1) {
        if (ltid(wv) == 0) { bst[0] = 0u; bst[1] = 0u; PP p0 = (PP)__builtin_amdgcn_kernarg_segment_ptr(); (void)xb_add(&((unsigned*)(p0->ws + O_BAR))[XB_XCNT(xb_xcc_id())], 1u); }
        __syncthreads();
    }
    for (int ph = ph0; ph < ph1; ++ph) {
        PP p = (PP)__builtin_amdgcn_kernarg_segment_ptr();
        asm volatile("" : "+s"(p));
        unsigned char* ws = p->ws;
        if (ph0 < 0) cg::this_grid().sync();
        else if (ph > ph0) xcd_barrier(wv, (unsigned*)(ws + O_BAR), bst);
#ifdef ONLY_OP
        const int op = ONLY_OP; const int layer = p->lay[ph];
#else
        const int op = p->op[ph], layer = p->lay[ph];
#endif
        const bool lastl = layer == 3;
        const bool ctx_dead = lastl || (layer == 2 && (op == OP_RES_LOUT || op == OP_NORM_MLP || op == OP_G_MLP1 || op == OP_RES_MLP2));
        const int M = ctx_dead ? NLAT : NTOK;
        const float* modl = (const float*)(ws + O_MOD) + (size_t)layer * 17 * 6144;
        bf16_t* xb = (bf16_t*)(ws + O_XB);
        const int fj = layer == 3 ? 1 : 0;
        switch (op) {
        case OP_PREP: prep_phase(wv, p, lds); break;
        case OP_NORM_MIX: {
            const bool fix = layer == 1 || layer == 2;
            if (layer == 0) norm_phase<true>(wv, p->x, p->ctx, xb, p->norm_mix_g, modl, 0, 1024, (bf16_t*)(ws + O_H), M);
            else norm_phase<false>(wv, nullptr, nullptr, xb, p->norm_mix_g + layer * 1024, modl, 0, 1024, (bf16_t*)(ws + O_H), M, fix ? (const float*)(ws + O_PART) : nullptr,
                                   (const float*)(ws + O_MOD) + ((size_t)(layer - 1) * 17 + 16) * 6144 + 5120);
            if (layer == 0 || layer == 3) dmat_gen(wv, (bf16_t*)(ws + O_CST), lds);
        } break;
        case OP_NORM_MLP: norm_phase<false>(wv, nullptr, nullptr, xb, p->norm_mlp_g + layer * 1024, modl, 3072, 4096, (bf16_t*)(ws + O_H), M); break;
        case OP_G_PQ: { EpiPQT E; E.PP = (bf16_t*)(ws + O_PQTP); E.PQ = (bf16_t*)(ws + O_PQTQ); E.P64 = (bf16_t*)(ws + O_PQT64); E.PC = (bf16_t*)(ws + O_PQTC);
            run_gemm(wv, lds3, (const bf16_t*)(ws + O_WPQT) + (size_t)fj * 1024 * 1024, 1024, (const bf16_t*)(ws + O_H), 1024, M, 1024, E); } break;
        case OP_FOLD: fold_phase(wv, (const bf16_t*)(ws + O_PQTP), (bf16_t*)(ws + O_FOLD)); break;
        case OP_G_DFT: case OP_G_DFTC: {
#pragma nounroll
            for (int gi = 0; gi < 3; ++gi) { const int g = gi == 0 ? 2 : gi - 1;
                if (g == 0 && lastl) continue;
                EpiDFTS E; E.F = (bf16_t*)(ws + O_F); E.mode = g == 2 ? 0 : (g == 1 ? 1 : 2); E.scale = g == 0 ? 0.005524271728019903f : 0.0013810679320049757f;
                const bf16_t* A = (const bf16_t*)(ws + (g == 0 ? O_D256 : O_CST)); const bf16_t* Bt = g == 0 ? (const bf16_t*)(ws + O_PQTC) : (const bf16_t*)(ws + O_FOLD) + (g == 1 ? (size_t)16384 * KF : 0);
                const int Mg = g == 0 ? 512 : 2048, Ng = g == 1 ? 256 : 16384, Kg = g == 0 ? 256 : KF;
                pg8::DftOrder S; S.init(Mg, Ng, (int)gridDim.x, g == 1 ? (int)((blockIdx.x + gridDim.x - 128) % gridDim.x) : (int)blockIdx.x); S.kq = g == 2 ? 2048 * KF * 2 : 0; S.kcls = g == 0 ? 0 : (int)FOLD_CLS;
                pg8::Gemm gm; gm.A = A; gm.Bt = Bt; gm.M = Mg; gm.N = Ng; gm.K = Kg; gm.lda = Kg; gm.ldb = Kg;
                pg8::gemm_phase<EpiDFTS, pg8::DftOrder>(wv, lds3, gm, S, E);
            }
            nyquist_pass(wv, (const bf16_t*)(ws + O_PQTP), (const bf16_t*)(ws + O_PQT64), (bf16_t*)(ws + O_F), 0.0013810679320049757f);
        } break;
        case OP_RES_FOUT: case OP_RES_MLP2: case OP_RES_WO: case OP_RES_LOUT: {
            const bool split = (op == OP_RES_MLP2 && layer < 2);
            const bf16_t* A; const bf16_t* Bt; int K;
            if (op == OP_RES_FOUT) { A = (const bf16_t*)(ws + O_F); Bt = (const bf16_t*)(ws + O_FWOT) + (size_t)fj * 1024 * 1024; K = 1024; }
            else if (op == OP_RES_MLP2) { A = (const bf16_t*)(ws + O_BIG); Bt = (const bf16_t*)(ws + O_W2T) + (size_t)layer * DFF * 1024; K = DFF; }
            else if (op == OP_RES_WO) { A = (const bf16_t*)(ws + O_H); Bt = (const bf16_t*)(ws + O_WOT); K = 1024; }
            else { A = (const bf16_t*)(ws + O_G); Bt = (const bf16_t*)(ws + O_LWOT); K = DRNN; }
#pragma nounroll
            for (int g = 0; g < (split ? 2 : 1); ++g) {
                EpiRes E; E.xb = xb; E.gate = modl + (op == OP_RES_MLP2 ? 5120 : 2048);
                E.part = g ? (float*)(ws + O_PART) : nullptr;
                pg8::ResOrder S; S.split = g;
                if (g == 0) S.init(split ? NLAT : M, 1024, (int)gridDim.x, (int)blockIdx.x); else S.init(NCTX, 4096, (int)gridDim.x, (int)blockIdx.x);
                pg8::Gemm gm; gm.A = g ? A + (size_t)NLAT * DFF : A; gm.Bt = Bt; gm.M = 0; gm.N = 0; gm.K = g ? 1024 : K; gm.lda = K; gm.ldb = K;
                pg8::gemm_phase<EpiRes, pg8::ResOrder>(wv, lds3, gm, S, E);
            } } break;
        case OP_G_MLP1: { EpiRelu2 E; E.O = (bf16_t*)(ws + O_BIG); E.ldc = DFF;
            run_gemm(wv, lds3, (const bf16_t*)(ws + O_H), 1024, (const bf16_t*)(ws + O_W1T) + (size_t)layer * DFF * 1024, M, DFF, 1024, E); } break;
        case OP_G_QKV: { EpiQKV E; E.Q = (bf16_t*)(ws + O_Q); E.KB = (bf16_t*)(ws + O_KB); E.VB = (bf16_t*)(ws + O_VB); E.qg = p->q_g; E.kg = p->k_g; E.rope = (const float*)(ws + O_ROPE); E.red = (LAS float*)(lds3 + 131072 + 4096);
            run_gemm(wv, lds3, (const bf16_t*)(ws + O_H), 1024, (const bf16_t*)(ws + O_WQKVT), M, 1536, 1024, E); } break;
        case OP_QKNORM: qknorm_phase(wv, (const bf16_t*)(ws + O_QKVRAW), (bf16_t*)(ws + O_Q), (bf16_t*)(ws + O_KB), (bf16_t*)(ws + O_VB), p->q_g, p->k_g, lds); break;
        case OP_ATTN: attn_phase(wv, (const bf16_t*)(ws + O_Q), (const bf16_t*)(ws + O_KB), (const bf16_t*)(ws + O_VB), (bf16_t*)(ws + O_H), lds); break;
        case OP_G_LRUIN: { EpiLruIn E; E.G = (bf16_t*)(ws + O_G); E.XR = (bf16_t*)(ws + O_XR);
            run_gemm(wv, lds3, (const bf16_t*)(ws + O_H), 1024, (const bf16_t*)(ws + O_LWINT), M, 2560, 1024, E); } break;
        case OP_CONV: conv_phase(wv, (const bf16_t*)(ws + O_XR), (bf16_t*)(ws + O_XCONV), p->conv_w, p->conv_b); break;
        case OP_G_GATE0: case OP_G_GATE1: { const int d = op == OP_G_GATE1 ? 1 : 0;
            EpiGate E; E.XC = (const bf16_t*)(ws + O_XCONV); E.LA = (bf16_t*)(ws + O_LA); E.U = (bf16_t*)p->out; E.ba = p->ga_b + d * DRNN; E.bx = p->gx_b + d * DRNN; E.lam = p->lam + d * DRNN;
            run_gemm<EpiGate, pg8::GateOrder>(wv, lds3, (const bf16_t*)(ws + O_XCONV), DRNN, (const bf16_t*)(ws + O_GATET) + (size_t)d * 2560 * 256, M, 2560, 256, E); } break;
        case OP_SCAN0: scan_phase(wv, 0, (const bf16_t*)(ws + O_LA), (const bf16_t*)p->out, (bf16_t*)(ws + O_XR), (bf16_t*)(ws + O_G), lds); break;
        case OP_SCAN1: scan_phase(wv, 1, (const bf16_t*)(ws + O_LA), (const bf16_t*)p->out, (bf16_t*)(ws + O_XR), (bf16_t*)(ws + O_G), lds); break;
        case OP_FINAL: final_phase(wv, xb, p->out, p->final_g); break;
        default: break;
        }
    }
}

extern "C" void kernel_launch(void* const* d_in, const int* in_sizes, int n_in, void* d_out, int out_size, void* d_ws, size_t ws_size, hipStream_t stream) {
    Params p; memset(&p, 0, sizeof(p));
    const float** f = (const float**)&p;
    for (int i = 0; i < 26 && i < n_in; ++i) f[i] = (const float*)d_in[i];
    p.out = (float*)d_out; p.ws = (unsigned char*)d_ws;
    int n = 0;
#ifndef PROBE_DUP
#define PROBE_DUP -1
#endif
    auto add = [&](int op, int layer) { const int reps = (op == PROBE_DUP) ? 2 : 1; for (int r = 0; r < reps; ++r) { p.op[n] = (unsigned char)op; p.lay[n] = (unsigned char)layer; ++n; } };
    add(OP_PREP, 0);
    add(OP_NORM_MIX, 0); add(OP_G_PQ, 0); add(OP_FOLD, 0); add(OP_G_DFT, 0); add(OP_RES_FOUT, 0); add(OP_NORM_MLP, 0); add(OP_G_MLP1, 0); add(OP_RES_MLP2, 0);
    add(OP_NORM_MIX, 1); add(OP_G_QKV, 1); add(OP_ATTN, 1); add(OP_RES_WO, 1); add(OP_NORM_MLP, 1); add(OP_G_MLP1, 1); add(OP_RES_MLP2, 1);
    add(OP_NORM_MIX, 2); add(OP_G_LRUIN, 2); add(OP_CONV, 2); add(OP_G_GATE0, 2); add(OP_SCAN0, 2); add(OP_G_GATE1, 2); add(OP_SCAN1, 2); add(OP_RES_LOUT, 2);
    add(OP_NORM_MLP, 2); add(OP_G_MLP1, 2); add(OP_RES_MLP2, 2);
    add(OP_NORM_MIX, 3); add(OP_G_PQ, 3); add(OP_FOLD, 3); add(OP_G_DFT, 3); add(OP_RES_FOUT, 3); add(OP_NORM_MLP, 3); add(OP_G_MLP1, 3); add(OP_RES_MLP2, 3);
    add(OP_FINAL, 3);
    static int grid = 0;
    if (!grid) {
        hipFuncSetAttribute((const void*)mk, hipFuncAttributeMaxDynamicSharedMemorySize, LDS_BYTES);
        int dev = 0, cus = 0, per_cu = 0; hipGetDevice(&dev); hipDeviceGetAttribute(&cus, hipDeviceAttributeMultiprocessorCount, dev);
        hipOccupancyMaxActiveBlocksPerMultiprocessor(&per_cu, mk, 512, LDS_BYTES);
        if (per_cu < 1) { fprintf(stderr, "occupancy query returned %d\n", per_cu); per_cu = 1; }
        grid = cus > 0 ? cus : 256;
    }
#if MK_LAUNCHES == 1
    hipMemsetAsync((char*)d_ws + O_BAR, 0, BAR_BYTES, stream);
    int ph0 = 0, ph1 = n; void* args[] = {&p, &ph0, &ph1};
    hipError_t e = hipLaunchCooperativeKernel((void*)mk, dim3(grid), dim3(512), args, LDS_BYTES, stream);
    if (e != hipSuccess) fprintf(stderr, "cooperative launch failed: %s\n", hipGetErrorString(e));
#else
    for (int ph = 0; ph < n; ++ph) hipLaunchKernelGGL(mk, dim3(grid), dim3(512), LDS_BYTES, stream, p, ph, ph + 1);
#endif
}
```

```cpp
#include <hip/hip_runtime.h>
#include <hip/hip_cooperative_groups.h>
#include <cstdio>
#include <cstring>
#include <cstdint>
namespace cg = cooperative_groups;

#ifndef MK_LAUNCHES
#define MK_LAUNCHES 1
#endif

#define LAS __attribute__((address_space(3)))
typedef unsigned short bf16_t;
typedef short bf16x8 __attribute__((ext_vector_type(8)));
typedef short s16x4 __attribute__((ext_vector_type(4)));
typedef float f32x4 __attribute__((ext_vector_type(4)));
typedef float f32x16 __attribute__((ext_vector_type(16)));
typedef unsigned u32x4 __attribute__((ext_vector_type(4)));
typedef unsigned u32x2 __attribute__((ext_vector_type(2)));

constexpr int DM = 1024, NBATCH = 16, SEQ = 4096, TCTX = 256, NLAT = NBATCH * SEQ, NCTX = NBATCH * TCTX, NTOK = NLAT + NCTX;
constexpr int DFF = 4096, DRNN = 1280, SKV = SEQ + TCTX;
constexpr int LDS_BYTES = 131072 + 4096 + 8192;

constexpr size_t al256(size_t x) { return (x + 255) & ~(size_t)255; }
constexpr size_t O_MOD = 0;
constexpr size_t O_XB = al256(O_MOD + 4ull * 17 * 6144 * 4);
constexpr size_t O_W1T = O_XB + (size_t)NTOK * DM * 2;
constexpr size_t O_W2T = O_W1T + 4ull * DFF * DM * 2;
constexpr size_t O_WPQT = O_W2T + 4ull * DFF * DM * 2;
constexpr size_t O_FWOT = O_WPQT + 2ull * 2048 * 1024 * 2;
constexpr size_t O_WQKVT = O_FWOT + 2ull * 1024 * 1024 * 2;
constexpr size_t O_WOT = O_WQKVT + 1536ull * 1024 * 2;
constexpr size_t O_LWINT = O_WOT + 1024ull * 1024 * 2;
constexpr size_t O_GATET = O_LWINT + 2560ull * 1024 * 2;
constexpr size_t O_LWOT = O_GATET + 2ull * 2560 * 256 * 2;
constexpr size_t O_D256 = O_LWOT + 1024ull * 1280 * 2;
constexpr size_t O_ROPE = al256(O_D256 + 256ull * 512 * 2);
constexpr size_t O_GPAR = al256(O_ROPE + 64ull * 32 * 2 * 4);
constexpr size_t O_BAR = al256(O_GPAR + 2ull * 3 * 1280 * 4);
constexpr size_t BAR_BYTES = 16384;
constexpr size_t O_TMP = al256(O_BAR + BAR_BYTES);
constexpr size_t O_H = O_TMP;
constexpr size_t O_BIG = O_H + (size_t)NTOK * DM * 2;
constexpr size_t BIG_END = O_BIG + (size_t)NTOK * DFF * 2;
constexpr size_t O_PQTP = O_BIG;
constexpr size_t O_PQTQ = O_PQTP + 8192ull * 4096 * 2;
constexpr size_t O_PQT64 = O_PQTQ + 8192ull * 4096 * 2;
constexpr size_t O_PQTC = O_PQT64 + 256ull * 4096 * 2;
constexpr int KF = 1152;
constexpr size_t O_CST = O_PQTC + 16ull * 1024 * 256 * 2;
constexpr size_t FOLD_CLS = 16640ull * KF * 2;
constexpr size_t O_FOLD = O_CST + 4ull * 1024 * KF * 2;
constexpr size_t O_F = al256(O_FOLD + 2 * FOLD_CLS);
static_assert(O_F + (size_t)NTOK * DM * 2 <= BIG_END, "fourier temporaries");
constexpr size_t O_QKVRAW = O_BIG;
constexpr size_t O_Q = O_QKVRAW + (size_t)NTOK * 1536 * 2;
constexpr size_t O_KB = O_Q + (size_t)NTOK * 1024 * 2;
constexpr size_t O_VB = O_KB + 16ull * SKV * 256 * 2;
static_assert(O_VB + 16ull * SKV * 256 * 2 <= BIG_END, "attention temporaries");
constexpr size_t LRU_SLOT = (size_t)NTOK * DRNN * 2;
constexpr size_t O_XCONV = O_TMP, O_G = O_TMP + LRU_SLOT, O_XR = O_TMP + 2 * LRU_SLOT, O_LA = O_TMP + 3 * LRU_SLOT;
static_assert(O_TMP + 4 * LRU_SLOT <= (1ull << 30), "lru temporaries");
static_assert(LRU_SLOT <= (size_t)NLAT * DM * 4, "U slot fits d_out");
constexpr size_t O_PART = BIG_END;
static_assert(O_PART + 4ull * NCTX * DM * 4 <= (1ull << 30), "ws");
static_assert(O_G >= O_H + (size_t)NTOK * DM * 2, "G must not overlap H");

enum { OP_PREP = 0, OP_NORM_MIX, OP_NORM_MLP, OP_G_PQ, OP_G_DFT, OP_RES_FOUT, OP_G_MLP1, OP_RES_MLP2, OP_G_QKV, OP_QKNORM, OP_ATTN, OP_RES_WO,
       OP_G_LRUIN, OP_CONV, OP_G_GATE0, OP_SCAN0, OP_G_GATE1, OP_SCAN1, OP_RES_LOUT, OP_FINAL, OP_G_DFTC, OP_FOLD };

struct Params {
    const float *x, *c, *ctx, *c_ctx, *ada_w, *ada_b, *norm_mix_g, *norm_mlp_g, *mlp_w1, *mlp_w2, *fnet_w_in, *fnet_w_out, *attn_w_qkv, *attn_w_o, *q_g, *k_g,
        *lru_w_in, *conv_w, *conv_b, *ga_w, *ga_b, *gx_w, *gx_b, *lam, *lru_w_out, *final_g;
    float* out; unsigned char* ws;
    unsigned char op[48]; unsigned char lay[48];
};

__device__ __forceinline__ unsigned cvtpk(float lo, float hi) { unsigned r; asm volatile("v_cvt_pk_bf16_f32 %0, %1, %2" : "=v"(r) : "v"(lo), "v"(hi)); return r; }
__device__ __forceinline__ float bflo(unsigned w) { return __uint_as_float(w << 16); }
__device__ __forceinline__ float bfhi(unsigned w) { return __uint_as_float(w & 0xffff0000u); }
__device__ __forceinline__ float bf1(bf16_t h) { return __uint_as_float(((unsigned)h) << 16); }
__device__ __forceinline__ bf16_t f2bf(float f) { return (bf16_t)(cvtpk(f, 0.f) & 0xffffu); }
__device__ __forceinline__ float lane_xor(float v, int lane, int o) { return __int_as_float(__builtin_amdgcn_ds_bpermute((lane ^ o) << 2, __float_as_int(v))); }
__device__ __forceinline__ float wave_sum(float v, int lane) {
#pragma unroll
    for (int o = 32; o >= 1; o >>= 1) v += lane_xor(v, lane, o);
    return v;
}
__device__ __forceinline__ int ltid(const int wv) {
    int lane; asm volatile("v_mbcnt_lo_u32_b32 %0, -1, 0\n\tv_mbcnt_hi_u32_b32 %0, -1, %0" : "=v"(lane));
    int t = (wv << 6) | lane; asm volatile("" : "+v"(t)); return t; }
__device__ __forceinline__ float sigmoidf_(float z) { return 1.f / (1.f + __expf(-z)); }

#define XB_TMO      128
#define XB_XCNT(j)  (256  + 64 * (j))
#define XB_XSUB(j)  (1280 + 64 * (j))
#define XB_XGEN(j)  (2304 + 64 * (j))
#define XB_TOP      3328
#define XB_TOPGEN   3392
#define XCD_BAR_WORDS 3456
#define XB_SPIN_CAP (1u << 18)
__device__ __forceinline__ unsigned xb_ld(unsigned* p)              { return __hip_atomic_load(p, __ATOMIC_RELAXED, __HIP_MEMORY_SCOPE_AGENT); }
__device__ __forceinline__ unsigned xb_add(unsigned* p, unsigned v) { return __hip_atomic_fetch_add(p, v, __ATOMIC_RELAXED, __HIP_MEMORY_SCOPE_AGENT); }
__device__ __forceinline__ unsigned xb_xcc_id() { return (unsigned)__builtin_amdgcn_s_getreg((3 << 11) | 20) & 0xFu; }
#define XB_SPIN(cond, bar) do { unsigned _sp = 0; while (cond) { __builtin_amdgcn_s_sleep(1); \
    if ((++_sp & 255u) == 0u) { if (xb_ld(&(bar)[XB_TMO])) break; if (_sp > XB_SPIN_CAP) { atomicAdd(&(bar)[XB_TMO], 1u); break; } } } } while (0)
__device__ __forceinline__ void xcd_barrier_complete(unsigned* bar, unsigned x, unsigned& nloc, unsigned& nx) {
    const unsigned G = gridDim.x * gridDim.y * gridDim.z;
    unsigned sum, cnt, mine, sp = 0u;
    for (;;) {
        sum = 0u; cnt = 0u; mine = 0u;
#pragma unroll
        for (unsigned j = 0; j < 16; ++j) { const unsigned c = xb_ld(&bar[XB_XCNT(j)]); sum += c; cnt += (c > 0u) ? 1u : 0u; mine = (j == x) ? c : mine; }
        if (sum == G) break;
        __builtin_amdgcn_s_sleep(1);
        if ((++sp & 255u) == 0u) { if (xb_ld(&bar[XB_TMO])) break; if (sp > XB_SPIN_CAP) { atomicAdd(&bar[XB_TMO], 1u); break; } }
    }
    nloc = mine > 0u ? mine : 1u; nx = cnt > 0u ? cnt : 1u;
}
__device__ __forceinline__ void xcd_barrier(const int wv, unsigned* bar, volatile LAS unsigned* st) {
    asm volatile("s_waitcnt vmcnt(0)" ::: "memory");
    __syncthreads();
    if (ltid(wv) == 0) {
        const unsigned x = xb_xcc_id();
        __builtin_amdgcn_s_waitcnt(0);
        unsigned nloc = st[0], nx = st[1];
        if (nloc == 0u) { xcd_barrier_complete(bar, x, nloc, nx); st[0] = nloc; st[1] = nx; }
        const unsigned old = xb_add(&bar[XB_XSUB(x)], 1u);
        const unsigned gen = old / nloc;
        if (old + 1u == (gen + 1u) * nloc) {
            __builtin_amdgcn_fence(__ATOMIC_RELEASE, "agent");
            asm volatile("s_waitcnt vmcnt(0)" ::: "memory");
            const unsigned og = xb_add(&bar[XB_TOP], 1u);
            const unsigned tg = og / nx;
            if (og + 1u == (tg + 1u) * nx) xb_add(&bar[XB_TOPGEN], 1u);
            else XB_SPIN(xb_ld(&bar[XB_TOPGEN]) == tg, bar);
            __builtin_amdgcn_fence(__ATOMIC_ACQUIRE, "agent");
            xb_add(&bar[XB_XGEN(x)], 1u);
            asm volatile("s_waitcnt vmcnt(0)" ::: "memory");
        } else {
            XB_SPIN(xb_ld(&bar[XB_XGEN(x)]) == gen, bar);
            __builtin_amdgcn_fence(__ATOMIC_ACQUIRE, "agent");
            asm volatile("s_waitcnt vmcnt(0)" ::: "memory");
        }
    }
    __syncthreads();
}

namespace pg8 {
constexpr int BM = 256, BK = 64, HALF = 128, HTB = HALF * BK * 2, STAGE_BYTES = 8 * HTB, NXCD = 8, WGM = 8;
__device__ __forceinline__ int lds_byte(int r, int c) { const int st = (r >> 4) * 2 + (c >> 5), rr = r & 15, cc = c & 31, ob = rr * 64 + cc * 2; return st * 1024 + (ob ^ (((ob >> 9) & 1) << 5)); }
__device__ __forceinline__ void stage_rc(int b, int& R, int& C) { const int st = b / 1024, sb = b % 1024, swz = sb ^ (((sb >> 9) & 1) << 5); R = (st >> 1) * 16 + swz / 64; C = (st & 1) * 32 + (swz % 64) / 2; }
__device__ __forceinline__ int perm32(int rho) { const int n = rho >> 4, i = rho & 15; return 8 * (i >> 2) + 4 * n + (i & 3); }
struct Unit { int pm, pn, koff, koffB, ks; };
struct Gemm { const bf16_t* A; const bf16_t* Bt; int M, N, K, lda, ldb; };
struct StaticOrder {
    int nM, nN, nwg, G, c;
    __device__ void init(int M, int N, int G_, int c_) { nM = M / BM; nN = N / BM; nwg = nM * nN; G = G_; c = c_; }
    __device__ bool next(int i, Unit& u) const {
        const long L = (long)i * G + c; if (L >= nwg) return false;
        int wgid = (int)L; { const int q = nwg / NXCD, r = nwg % NXCD, xcd = wgid % NXCD, off = wgid / NXCD; wgid = (xcd < r ? xcd * (q + 1) : r * (q + 1) + (xcd - r) * q) + off; }
        const int nig = WGM * nN, gid = wgid / nig, fm = gid * WGM, gsz = (nM - fm) < WGM ? (nM - fm) : WGM;
        u.pm = fm + ((wgid % nig) % gsz); u.pn = (wgid % nig) / gsz; u.koff = 0; u.koffB = 0; u.ks = 0; return true;
    }
};
struct DftOrder : StaticOrder {
    int kq, kcls;
    __device__ bool next(int i, Unit& u) const { if (!StaticOrder::next(i, u)) return false; u.koff = (u.pn >= 32) ? kq : 0; u.koffB = (u.pm >> 2) * kcls; return true; }
};
struct ResOrder : StaticOrder {
    int split;
    __device__ bool next(int i, Unit& u) const { if (!StaticOrder::next(i, u)) return false; if (split) { const int ks = u.pn >> 2; u.pn &= 3; u.koff = ks * 2048; u.koffB = ks * 2048; u.ks = ks; } return true; }
};
struct GateOrder : StaticOrder {
    __device__ bool next(int i, Unit& u) const { if (!StaticOrder::next(i, u)) return false; u.koff = (u.pn >> 1) * 512; return true; }
};

template <class Epi, class Sched>
__device__ __forceinline__ void gemm_phase(const int wv, LAS unsigned char* lds, const Gemm g, const Sched& S, const Epi& E) {
    const int tid = ltid(wv), wid = __builtin_amdgcn_readfirstlane(tid >> 6), lane = tid & 63, wr = wid >> 2, wc = wid & 3, fr = lane & 15, fq = lane >> 4;
    const int K = g.K, nt = K / BK, lda = g.lda, ldb = g.ldb;
    unsigned voffA[2], voffB[2];
#pragma unroll
    for (int i = 0; i < 2; ++i) { int R, C; stage_rc(tid * 16 + i * 8192, R, C); const int Rb = Epi::PERM ? ((R & ~31) + perm32(R & 31)) : R; voffA[i] = (unsigned)(R * lda + C) * 2u; voffB[i] = (unsigned)(Rb * ldb + C) * 2u; }
    const size_t kstep = (size_t)(BK * 2);
    const size_t hstepA = (size_t)HALF * lda * 2, hstepB = (size_t)HALF * ldb * 2;
    const size_t tstepA = 2 * hstepA, tstepB = 2 * hstepB;
    const unsigned ldsw = (unsigned)wid * 1024u;
    const int aoff = lds_byte(wr * 64 + fr, fq * 8), boff = lds_byte(wc * 32 + fr, fq * 8);
#define PG8_SA(b, h) (((b) * 2 + (h)) * HTB)
#define PG8_SB(b, h) ((4 + (b) * 2 + (h)) * HTB)
#define PG8_STAGE(bufoff, gbase, voff) do { _Pragma("unroll") for (int _i = 0; _i < 2; ++_i) \
        __builtin_amdgcn_global_load_lds((const unsigned*)((const char*)(gbase) + (voff)[_i]), (LAS unsigned*)(lds + (bufoff) + ldsw + _i * 8192), 16, 0, 0); } while (0)
#define PG8_LDA(dst, b, h) do { _Pragma("unroll") for (int m = 0; m < 4; ++m) _Pragma("unroll") for (int k = 0; k < 2; ++k) dst[m][k] = *(const LAS bf16x8*)(lds + PG8_SA(b, h) + aoff + m * 2048 + k * 1024); } while (0)
#define PG8_LDB(dst, b, h) do { _Pragma("unroll") for (int n = 0; n < 2; ++n) _Pragma("unroll") for (int k = 0; k < 2; ++k) dst[n][k] = *(const LAS bf16x8*)(lds + PG8_SB(b, h) + boff + n * 2048 + k * 1024); } while (0)
#define PG8_MMA(ai, bj, At, Bt) do { __builtin_amdgcn_s_setprio(1); _Pragma("unroll") for (int m = 0; m < 4; ++m) _Pragma("unroll") for (int n = 0; n < 2; ++n) _Pragma("unroll") for (int k = 0; k < 2; ++k) \
        acc[ai][bj][m][n] = __builtin_amdgcn_mfma_f32_16x16x32_bf16(Bt[n][k], At[m][k], acc[ai][bj][m][n], 0, 0, 0); __builtin_amdgcn_s_setprio(0); } while (0)
#define PG8_WAIT_V(n) asm volatile("s_waitcnt vmcnt(" #n ")" ::: "memory")
#define PG8_WAIT_L(n) asm volatile("s_waitcnt lgkmcnt(" #n ")" ::: "memory")
#define PG8_BAR __builtin_amdgcn_s_barrier()
#define PG8_SCHED __builtin_amdgcn_sched_barrier(0)
    Unit cur, nxt; int ui = 0;
    if (!S.next(0, cur)) return;
    f32x4 acc[2][2][4][2];
#pragma unroll
    for (int a = 0; a < 2; ++a)
#pragma unroll
        for (int b = 0; b < 2; ++b)
#pragma unroll
            for (int m = 0; m < 4; ++m)
#pragma unroll
                for (int n = 0; n < 2; ++n) acc[a][b][m][n] = (f32x4){0.f, 0.f, 0.f, 0.f};
    bf16x8 At[4][2], B0[2][2], B1[2][2];
    const char* cA = (const char*)g.A + (size_t)cur.pm * tstepA + cur.koff; const char* cB = (const char*)g.Bt + (size_t)cur.pn * tstepB + cur.koffB;
    PG8_STAGE(PG8_SB(0, 0), cB, voffB); PG8_STAGE(PG8_SA(0, 0), cA, voffA); PG8_STAGE(PG8_SB(0, 1), cB + hstepB, voffB); PG8_STAGE(PG8_SA(0, 1), cA + hstepA, voffA);
    if (wr == 1) PG8_BAR;
    PG8_WAIT_V(4); PG8_BAR;
    PG8_STAGE(PG8_SB(1, 0), cB + kstep, voffB); PG8_STAGE(PG8_SA(1, 0), cA + kstep, voffA); PG8_STAGE(PG8_SB(1, 1), cB + hstepB + kstep, voffB);
    PG8_WAIT_V(6); PG8_BAR;
    for (;;) {
        const bool has_next = S.next(ui + 1, nxt);
        const char* nA = has_next ? (const char*)g.A + (size_t)nxt.pm * tstepA + nxt.koff : cA; const char* nB = has_next ? (const char*)g.Bt + (size_t)nxt.pn * tstepB + nxt.koffB : cB;
        for (int t = 0; t < nt; t += 2) {
            const bool last = (t == nt - 2);
            const char* a1 = cA + (size_t)(t + 1) * kstep;
            const char* a2 = last ? nA : cA + (size_t)(t + 2) * kstep; const char* b2 = last ? nB : cB + (size_t)(t + 2) * kstep;
            const char* a3 = a2 + kstep; const char* b3 = b2 + kstep;
            PG8_LDB(B0, 0, 0); PG8_SCHED; PG8_LDA(At, 0, 0); PG8_STAGE(PG8_SA(1, 1), a1 + hstepA, voffA);
            PG8_WAIT_L(8); PG8_BAR; PG8_WAIT_L(0); PG8_MMA(0, 0, At, B0); PG8_BAR; PG8_SCHED;
            PG8_LDB(B1, 0, 1); PG8_STAGE(PG8_SB(0, 0), b2, voffB);
            PG8_BAR; PG8_WAIT_L(0); PG8_MMA(0, 1, At, B1); PG8_BAR;
            PG8_LDA(At, 0, 1); PG8_STAGE(PG8_SA(0, 0), a2, voffA);
            PG8_BAR; PG8_WAIT_L(0); PG8_MMA(1, 0, At, B0); PG8_BAR; PG8_SCHED;
            PG8_STAGE(PG8_SB(0, 1), b2 + hstepB, voffB);
            PG8_WAIT_V(6); PG8_BAR; PG8_MMA(1, 1, At, B1); PG8_BAR;
            PG8_LDB(B0, 1, 0); PG8_SCHED; PG8_LDA(At, 1, 0); PG8_STAGE(PG8_SA(0, 1), a2 + hstepA, voffA);
            PG8_WAIT_L(8); PG8_BAR; PG8_WAIT_L(0); PG8_MMA(0, 0, At, B0); PG8_BAR; PG8_SCHED;
            PG8_LDB(B1, 1, 1); PG8_STAGE(PG8_SB(1, 0), b3, voffB);
            PG8_BAR; PG8_WAIT_L(0); PG8_MMA(0, 1, At, B1); PG8_BAR;
            PG8_LDA(At, 1, 1); PG8_STAGE(PG8_SA(1, 0), a3, voffA);
            PG8_BAR; PG8_WAIT_L(0); PG8_MMA(1, 0, At, B0); PG8_BAR; PG8_SCHED;
            PG8_STAGE(PG8_SB(1, 1), b3 + hstepB, voffB);
            PG8_WAIT_V(6); PG8_BAR; PG8_MMA(1, 1, At, B1); PG8_BAR;
        }
        E(acc, cur, wr, wc, fr, fq);
        if (!has_next) break;
#pragma unroll
        for (int a = 0; a < 2; ++a)
#pragma unroll
            for (int b = 0; b < 2; ++b)
#pragma unroll
                for (int m = 0; m < 4; ++m)
#pragma unroll
                    for (int n = 0; n < 2; ++n) acc[a][b][m][n] = (f32x4){0.f, 0.f, 0.f, 0.f};
        cur = nxt; cA = nA; cB = nB; ++ui;
    }
    PG8_WAIT_V(0);
    if (wr == 0) PG8_BAR;
    PG8_BAR;
#undef PG8_SA
#undef PG8_SB
#undef PG8_STAGE
#undef PG8_LDA
#undef PG8_LDB
#undef PG8_MMA
#undef PG8_WAIT_V
#undef PG8_WAIT_L
#undef PG8_BAR
#undef PG8_SCHED
}
}
using pg8::Unit;
typedef f32x4 Acc[2][2][4][2];

__device__ __forceinline__ void st_bf4(bf16_t* p, f32x4 v) { u32x2 w = {cvtpk(v[0], v[1]), cvtpk(v[2], v[3])}; *(u32x2*)p = w; }
__device__ __forceinline__ void st_bf8(bf16_t* p, f32x4 a, f32x4 b) { u32x4 w = {cvtpk(a[0], a[1]), cvtpk(a[2], a[3]), cvtpk(b[0], b[1]), cvtpk(b[2], b[3])}; *(u32x4*)p = w; }
__device__ __forceinline__ void st_bf8_o(bf16_t* base, unsigned eoff, f32x4 a, f32x4 b) { u32x4 w = {cvtpk(a[0], a[1]), cvtpk(a[2], a[3]), cvtpk(b[0], b[1]), cvtpk(b[2], b[3])}; *(u32x4*)((char*)base + (size_t)(eoff * 2u)) = w; }
__device__ __forceinline__ u32x4 ld_bf8_o(const bf16_t* base, unsigned eoff) { return *(const u32x4*)((const char*)base + (size_t)(eoff * 2u)); }
__device__ __forceinline__ void st_bf4_o(bf16_t* base, unsigned eoff, f32x4 v) { u32x2 w = {cvtpk(v[0], v[1]), cvtpk(v[2], v[3])}; *(u32x2*)((char*)base + (size_t)(eoff * 2u)) = w; }

struct EpiBf16 {
    static constexpr bool PERM = false;
    bf16_t* O; int ldc;
    __device__ __forceinline__ void operator()(const Acc& acc, const Unit& u, int wr, int wc, int fr, int fq) const {
        const int row0 = u.pm * 256 + wr * 64 + fr, col0 = u.pn * 256 + wc * 32 + 4 * fq;
#pragma unroll
        for (int ai = 0; ai < 2; ++ai)
#pragma unroll
            for (int m = 0; m < 4; ++m) { bf16_t* rp = O + (size_t)(row0 + ai * 128 + m * 16) * ldc + col0;
#pragma unroll
                for (int bj = 0; bj < 2; ++bj)
#pragma unroll
                    for (int n = 0; n < 2; ++n) st_bf4(rp + bj * 128 + n * 16, acc[ai][bj][m][n]); }
    }
};
struct EpiRelu2 {
    static constexpr bool PERM = true;
    bf16_t* O; int ldc;
    __device__ __forceinline__ void operator()(const Acc& acc, const Unit& u, int wr, int wc, int fr, int fq) const {
        const int row0 = u.pm * 256 + wr * 64 + fr, col0 = u.pn * 256 + wc * 32 + 8 * fq;
#pragma unroll
        for (int ai = 0; ai < 2; ++ai)
#pragma unroll
            for (int m = 0; m < 4; ++m) { bf16_t* rp = O + (size_t)(row0 + ai * 128 + m * 16) * ldc + col0;
#pragma unroll
                for (int bj = 0; bj < 2; ++bj) { f32x4 v0 = acc[ai][bj][m][0], v1 = acc[ai][bj][m][1];
#pragma unroll
                    for (int j = 0; j < 4; ++j) { const float t0 = fmaxf(v0[j], 0.f), t1 = fmaxf(v1[j], 0.f); v0[j] = t0 * t0; v1[j] = t1 * t1; }
                    const u32x4 w = {cvtpk(v0[0], v0[1]), cvtpk(v0[2], v0[3]), cvtpk(v1[0], v1[1]), cvtpk(v1[2], v1[3])};
                    *(u32x4*)(rp + bj * 128) = w; } }
    }
};
struct EpiPQT {
    static constexpr bool PERM = true;
    bf16_t* PP; bf16_t* PQ; bf16_t* P64; bf16_t* PC;
    __device__ __forceinline__ void operator()(const Acc& acc, const Unit& u, int wr, int wc, int fr_, int fq_) const {
        int fr = fr_, fq = fq_; asm volatile("" : "+v"(fr), "+v"(fq));
        const int row0 = u.pm * 256 + wr * 64 + fr, tok0 = u.pn * 256; const bool lat = tok0 < NLAT;
        const int b = lat ? (tok0 >> 12) : ((tok0 - NLAT) >> 8); const int c0 = (lat ? (tok0 & 4095) : 0) + wc * 32 + 8 * fq;
#pragma unroll
        for (int ai = 0; ai < 2; ++ai)
#pragma unroll
            for (int m = 0; m < 4; ++m) { const int n = row0 + ai * 128 + m * 16; bf16_t* rp;
                if (lat) rp = (n < 512 ? PP + (size_t)(b * 512 + n) * 4096 : n < 520 ? P64 + (size_t)(b * 8 + n - 512) * 4096 : PQ + (size_t)(b * 504 + n - 520) * 4096) + c0;
                else rp = PC + (size_t)(b * 1024 + n) * 256 + c0;
#pragma unroll
                for (int bj = 0; bj < 2; ++bj) st_bf8(rp + bj * 128, acc[ai][bj][m][0], acc[ai][bj][m][1]); }
    }
};
struct EpiDFTS {
    static constexpr bool PERM = true;
    bf16_t* F; float scale; int mode;
    __device__ __forceinline__ void operator()(const Acc& acc, const Unit& u, int wr, int wc, int fr_, int fq_) const {
        int fr = fr_, fq = fq_; asm volatile("" : "+v"(fr), "+v"(fq));
        const int r0 = wr * 64 + fr;
#pragma unroll
        for (int bj = 0; bj < 2; ++bj) { const int cl = wc * 32 + 8 * fq + bj * 128; int base; bool ok = true; float sgn = 1.f;
            if (mode == 0) { int bb, n;
                if (u.pn < 32) { const int c = u.pn * 256 + cl; bb = c >> 9; n = c & 511; }
                else { const int c = (u.pn - 32) * 256 + cl; ok = c < 8064; bb = c / 504; n = 520 + c - bb * 504; sgn = -1.f; }
                base = bb * (4096 * 1024) + n; }
            else if (mode == 1) { ok = (cl < 128) && (u.pn == 0); base = (cl >> 3) * (4096 * 1024) + 512 + (cl & 7); }
            else { const int c = u.pn * 256 + cl; const int bb = c >> 10, n = c & 1023; ok = (u.pm == 0) ? (n < 520) : (n >= 520); base = (NLAT + bb * 256) * 1024 + n; }
            if (ok) {
#pragma unroll
                for (int ai = 0; ai < 2; ++ai)
#pragma unroll
                    for (int m = 0; m < 4; ++m) { const f32x4 v0 = acc[ai][bj][m][0] * scale, v1 = acc[ai][bj][m][1] * scale; const int kk = r0 + ai * 128 + m * 16;
                        if (mode == 2) st_bf8_o(F, (unsigned)(base + kk * 1024), v0, v1);
                        else { const int k = 2 * ((u.pm & 3) * 256 + kk) + (u.pm >> 2); st_bf8_o(F, (unsigned)(base + k * 1024), v0, v1); if (k != 0) st_bf8_o(F, (unsigned)(base + (4096 - k) * 1024), v0 * sgn, v1 * sgn); } } }
            __builtin_amdgcn_sched_barrier(0); }
    }
};
struct EpiRes {
    static constexpr bool PERM = true;
    bf16_t* xb; const float* gate;
    float* part;
    __device__ __forceinline__ void operator()(const Acc& acc, const Unit& u, int wr, int wc, int fr_, int fq_) const {
        int fr = fr_, fq = fq_; asm volatile("" : "+v"(fr), "+v"(fq));
        if (part) { float* pp = part + ((size_t)u.ks * NCTX + u.pm * 256 + wr * 64 + fr) * 1024 + u.pn * 256 + wc * 32 + 8 * fq;
#pragma unroll
            for (int ai = 0; ai < 2; ++ai)
#pragma unroll
                for (int m = 0; m < 4; ++m)
#pragma unroll
                    for (int bj = 0; bj < 2; ++bj)
#pragma unroll
                        for (int n = 0; n < 2; ++n) *(f32x4*)(pp + (size_t)(ai * 128 + m * 16) * 1024 + bj * 128 + n * 4) = acc[ai][bj][m][n];
            return; }
        const int R0 = u.pm * 256; const int bidx = R0 < NLAT ? (R0 >> 12) : 16;
        const int r0 = wr * 64 + fr, col0 = u.pn * 256 + wc * 32 + 8 * fq; const float* gp = gate + bidx * 6144 + col0;
        const unsigned xo = (unsigned)((R0 + r0) * 1024 + col0);
        u32x4 xa[4], xq[4]; f32x4 g4[2][2];
#define RES_LOAD(X, BJ, AI) do { _Pragma("unroll") for (int m = 0; m < 4; ++m) X[m] = ld_bf8_o(xb, xo + (unsigned)(((AI) * 128 + m * 16) * 1024 + (BJ) * 128)); } while (0)
#define RES_PROC(X, BJ, AI) do { _Pragma("unroll") for (int m = 0; m < 4; ++m) { \
            const f32x4 x0 = (f32x4){bflo(X[m][0]), bfhi(X[m][0]), bflo(X[m][1]), bfhi(X[m][1])}, x1 = (f32x4){bflo(X[m][2]), bfhi(X[m][2]), bflo(X[m][3]), bfhi(X[m][3])}; \
            st_bf8_o(xb, xo + (unsigned)(((AI) * 128 + m * 16) * 1024 + (BJ) * 128), x0 + g4[BJ][0] * acc[AI][BJ][m][0], x1 + g4[BJ][1] * acc[AI][BJ][m][1]); } } while (0)
        RES_LOAD(xa, 0, 0);
#pragma unroll
        for (int bj = 0; bj < 2; ++bj)
#pragma unroll
            for (int n = 0; n < 2; ++n) g4[bj][n] = *(const f32x4*)(gp + bj * 128 + n * 4);
        RES_LOAD(xq, 0, 1); __builtin_amdgcn_sched_barrier(0);
        RES_PROC(xa, 0, 0); __builtin_amdgcn_sched_barrier(0);
        RES_LOAD(xa, 1, 0); __builtin_amdgcn_sched_barrier(0);
        RES_PROC(xq, 0, 1); __builtin_amdgcn_sched_barrier(0);
        RES_LOAD(xq, 1, 1); __builtin_amdgcn_sched_barrier(0);
        RES_PROC(xa, 1, 0); __builtin_amdgcn_sched_barrier(0);
        RES_PROC(xq, 1, 1);
#undef RES_LOAD
#undef RES_PROC
    }
};
__device__ __forceinline__ float gelu_tanh(float x) { const float z = 0.7978845608028654f * (x + 0.044715f * x * x * x); const float t = 1.f - 2.f * __builtin_amdgcn_rcpf(__expf(2.f * z) + 1.f); return 0.5f * x * (1.f + t); }
struct EpiLruIn {
    static constexpr bool PERM = true;
    bf16_t* G; bf16_t* XR;
    __device__ __forceinline__ void operator()(const Acc& acc, const Unit& u, int wr, int wc, int fr, int fq) const {
        const int row0 = u.pm * 256 + wr * 64 + fr; const int C0 = u.pn * 256; const bool isg = C0 < DRNN;
        bf16_t* base = isg ? G : XR; const int col0 = (isg ? C0 : C0 - DRNN) + wc * 32 + 8 * fq;
#pragma unroll
        for (int ai = 0; ai < 2; ++ai)
#pragma unroll
            for (int m = 0; m < 4; ++m) { bf16_t* rp = base + (size_t)(row0 + ai * 128 + m * 16) * DRNN + col0;
#pragma unroll
                for (int bj = 0; bj < 2; ++bj) { f32x4 v0 = acc[ai][bj][m][0], v1 = acc[ai][bj][m][1];
                    if (isg) {
#pragma unroll
                        for (int j = 0; j < 4; ++j) { v0[j] = gelu_tanh(v0[j]); v1[j] = gelu_tanh(v1[j]); } }
                    st_bf8(rp + bj * 128, v0, v1); } }
    }
};
struct EpiGate {
    static constexpr bool PERM = true;
    const bf16_t* XC; bf16_t* LA; bf16_t* U; const float* gpar;
    __device__ __forceinline__ void operator()(const Acc& acc, const Unit& u, int wr, int wc, int fr_, int fq_) const {
        int fr = fr_, fq = fq_; asm volatile("" : "+v"(fr), "+v"(fq));
        constexpr float L2E = 1.4426950408889634f;
        const int row0 = u.pm * 256 + wr * 64 + fr; const int ch0 = u.pn * 128 + wc * 32 + 8 * fq;
        u32x4 xall[2][4]; f32x4 ba4[2], bx4[2], sp4[2];
#pragma unroll
        for (int n = 0; n < 2; ++n) { ba4[n] = *(const f32x4*)(gpar + ch0 + n * 4); bx4[n] = *(const f32x4*)(gpar + DRNN + ch0 + n * 4); sp4[n] = *(const f32x4*)(gpar + 2 * DRNN + ch0 + n * 4); }
#pragma unroll
        for (int ai = 0; ai < 2; ++ai)
#pragma unroll
            for (int m = 0; m < 4; ++m) xall[ai][m] = ld_bf8_o(XC, (unsigned)((row0 + ai * 128 + m * 16) * DRNN + ch0));
        __builtin_amdgcn_sched_barrier(0);
#pragma unroll
        for (int ai = 0; ai < 2; ++ai)
#pragma unroll
            for (int m = 0; m < 4; ++m) { const unsigned o = (unsigned)((row0 + ai * 128 + m * 16) * DRNN + ch0); const u32x4 xw = xall[ai][m];
                u32x4 wl, wu;
#pragma unroll
                for (int n = 0; n < 2; ++n)
#pragma unroll
                    for (int jp = 0; jp < 2; ++jp) { float l2[2], u2[2];
#pragma unroll
                        for (int q = 0; q < 2; ++q) { const int j = jp * 2 + q; const unsigned xwd = xw[2 * n + jp]; const float xv = q ? bfhi(xwd) : bflo(xwd);
                            const float r = __builtin_amdgcn_rcpf(1.f + __builtin_amdgcn_exp2f(fmaf(acc[ai][0][m][n][j], -L2E, ba4[n][j])));
                            const float ig = __builtin_amdgcn_rcpf(1.f + __builtin_amdgcn_exp2f(fmaf(acc[ai][1][m][n][j], -L2E, bx4[n][j])));
                            l2[q] = r * sp4[n][j]; u2[q] = ig * xv; }
                        wl[2 * n + jp] = cvtpk(l2[0], l2[1]); wu[2 * n + jp] = cvtpk(u2[0], u2[1]); }
                *(u32x4*)((char*)LA + (size_t)(o * 2u)) = wl; *(u32x4*)((char*)U + (size_t)(o * 2u)) = wu; }
    }
};

struct EpiQKV {
    static constexpr bool PERM = true;
    bf16_t* Q; bf16_t* KB; bf16_t* VB; const float* qg; const float* kg; const float* rope; LAS float* red;
    __device__ __forceinline__ void operator()(const Acc& acc, const Unit& u, int wr, int wc, int fr_, int fq_) const {
        int fr = fr_, fq = fq_; asm volatile("" : "+v"(fr), "+v"(fq));
        const int R0 = u.pm * 256; const bool lat = R0 < NLAT; const int r0 = wr * 64 + fr; const int cw = wc * 32 + 8 * fq;
        const int krow0 = lat ? (R0 >> 12) * SKV + (R0 & 4095) : ((R0 - NLAT) >> 8) * SKV + SEQ;
        if (u.pn == 5) {
#pragma unroll
            for (int ai = 0; ai < 2; ++ai)
#pragma unroll
                for (int m = 0; m < 4; ++m) { bf16_t* vp = VB + (size_t)(krow0 + r0 + ai * 128 + m * 16) * 256 + cw;
#pragma unroll
                    for (int bj = 0; bj < 2; ++bj) st_bf8(vp + bj * 128, acc[ai][bj][m][0], acc[ai][bj][m][1]); }
            return; }
        const int lane = fr | (fq << 4);
#pragma unroll
        for (int ai = 0; ai < 2; ++ai)
#pragma unroll
            for (int m = 0; m < 4; ++m)
#pragma unroll
                for (int bj = 0; bj < 2; ++bj) { float sq = 0.f;
#pragma unroll
                    for (int n = 0; n < 2; ++n) { const f32x4 a = acc[ai][bj][m][n]; sq += a[0] * a[0] + a[1] * a[1] + a[2] * a[2] + a[3] * a[3]; }
                    sq += lane_xor(sq, lane, 16); sq += lane_xor(sq, lane, 32);
                    if (fq == 0) red[((r0 + ai * 128 + m * 16) * 2 + bj) * 4 + wc] = sq; }
        asm volatile("s_waitcnt lgkmcnt(0)" ::: "memory"); __builtin_amdgcn_s_barrier(); asm volatile("" ::: "memory");
        const float* gsel = (u.pn < 4 ? qg : kg) + cw; const f32x4 g4[2] = {*(const f32x4*)gsel, *(const f32x4*)(gsel + 4)};
        const int jb = (wc & 1) * 16 + 4 * fq;
#pragma unroll
        for (int ai = 0; ai < 2; ++ai) {
            f32x4 cs[4][2];
#pragma unroll
            for (int m = 0; m < 4; ++m) { const int t = (R0 + r0 + ai * 128 + m * 16) & 4095; const int pos = (wc < 2) ? (t >> 6) : (t & 63);
#pragma unroll
                for (int n = 0; n < 2; ++n) cs[m][n] = lat ? *(const f32x4*)(rope + (size_t)(pos * 32 + jb + 2 * n) * 2) : (f32x4){1.f, 0.f, 1.f, 0.f}; }
            __builtin_amdgcn_sched_barrier(0);
#pragma unroll
            for (int m = 0; m < 4; ++m) { const int row = r0 + ai * 128 + m * 16;
#pragma unroll
                for (int bj = 0; bj < 2; ++bj) { const f32x4 q = *(const LAS f32x4*)(red + (row * 2 + bj) * 4); const float rs = rsqrtf(((q[0] + q[1]) + (q[2] + q[3])) * (1.f / 128.f) + 1e-6f);
                    f32x4 y[2];
#pragma unroll
                    for (int n = 0; n < 2; ++n) { const f32x4 c4 = cs[m][n]; const f32x4 v = acc[ai][bj][m][n] * rs * g4[n];
                        y[n] = (f32x4){v[0] * c4[0] - v[1] * c4[1], v[0] * c4[1] + v[1] * c4[0], v[2] * c4[2] - v[3] * c4[3], v[2] * c4[3] + v[3] * c4[2]}; }
                    bf16_t* dp = (u.pn < 4) ? Q + (size_t)(R0 + row) * 1024 + u.pn * 256 + bj * 128 + cw : KB + (size_t)(krow0 + row) * 256 + bj * 128 + cw;
                    st_bf8(dp, y[0], y[1]); } }
            __builtin_amdgcn_sched_barrier(0); }
    }
};

template <class Epi, class Order = pg8::StaticOrder>
__device__ __forceinline__ void run_gemm(const int wv, LAS unsigned char* lds, const bf16_t* A, int lda, const bf16_t* Bt, int M, int N, int K, const Epi& E) {
    Order S; S.init(M, N, (int)gridDim.x, (int)blockIdx.x);
    pg8::Gemm g; g.A = A; g.Bt = Bt; g.M = M; g.N = N; g.K = K; g.lda = lda; g.ldb = K;
    pg8::gemm_phase<Epi, Order>(wv, lds, g, S, E);
}

namespace at {
constexpr int D = 128, NW = 8, QBLK = 32, KVBLK = 64;
constexpr float SCALE = 0.088388347648318440f, THR = 8.f;
constexpr int LDQ = 1024, LDK = 256, LDO = 1024;
constexpr size_t SHM_V = KVBLK * D * 2, SHM_K = KVBLK * D * 2;
#define KSWZ(row, colB) ((row) * 256 + ((colB) ^ (((row) & 7) << 4)))
#define SBAR() __builtin_amdgcn_sched_barrier(0)
__device__ __forceinline__ int crow(int r, int hi) { return (r & 3) + 8 * (r >> 2) + 4 * hi; }
__device__ __forceinline__ void partialSM(f32x16& p0, f32x16& p1, float& m_reg, float& mn, float& alpha) {
    constexpr float C = SCALE * 1.4426950408889634f;
    float pmax = p0[0];
#pragma unroll
    for (int r = 1; r < 16; ++r) pmax = fmaxf(pmax, p0[r]);
#pragma unroll
    for (int r = 0; r < 16; ++r) pmax = fmaxf(pmax, p1[r]);
    { auto rr = __builtin_amdgcn_permlane32_swap(__float_as_uint(pmax), __float_as_uint(pmax), false, false);
      pmax = fmaxf(__uint_as_float(rr[0]), __uint_as_float(rr[1])); }
    if (__builtin_expect(__all(pmax - m_reg <= THR / SCALE), 1)) { mn = m_reg; alpha = 1.f; }
    else { mn = fmaxf(m_reg, pmax); alpha = __builtin_amdgcn_exp2f((m_reg - mn) * C); m_reg = mn; }
    float mnC = -mn * C;
#pragma unroll
    for (int r = 0; r < 16; ++r) p0[r] = fmaf(p0[r], C, mnC);
#pragma unroll
    for (int r = 0; r < 16; ++r) p1[r] = fmaf(p1[r], C, mnC);
#pragma unroll
    for (int r = 0; r < 16; ++r) p0[r] = __builtin_amdgcn_exp2f(p0[r]);
}
__device__ __forceinline__ void finishSM(f32x16& p0, f32x16& p1, float alpha, float& l_reg, bf16x8& pa0, bf16x8& pa1, bf16x8& pa2, bf16x8& pa3) {
#pragma unroll
    for (int r = 0; r < 16; ++r) p1[r] = __builtin_amdgcn_exp2f(p1[r]);
    float ps = 0;
#pragma unroll
    for (int r = 0; r < 16; ++r) ps += p0[r];
#pragma unroll
    for (int r = 0; r < 16; ++r) ps += p1[r];
    { auto rr = __builtin_amdgcn_permlane32_swap(__float_as_uint(ps), __float_as_uint(ps), false, false);
      ps = __uint_as_float(rr[0]) + __uint_as_float(rr[1]); }
    l_reg = l_reg * alpha + ps;
#define PK4(P, BASE, OUT) do { unsigned a0 = cvtpk(P[BASE + 0], P[BASE + 1]), a1 = cvtpk(P[BASE + 2], P[BASE + 3]);   \
    unsigned b0 = cvtpk(P[BASE + 4], P[BASE + 5]), b1 = cvtpk(P[BASE + 6], P[BASE + 7]);                              \
    auto r0 = __builtin_amdgcn_permlane32_swap(a0, b0, false, false); auto r1 = __builtin_amdgcn_permlane32_swap(a1, b1, false, false); \
    u32x4 w = {r0[0], r1[0], r0[1], r1[1]}; OUT = *reinterpret_cast<bf16x8*>(&w); } while (0)
    PK4(p0, 0, pa0); PK4(p0, 8, pa1); PK4(p1, 0, pa2); PK4(p1, 8, pa3);
#undef PK4
}
__device__ __forceinline__ void qkt(f32x16& p0, f32x16& p1, const bf16_t* Ks, const bf16x8* qr, int r32, int hi) {
    p0 = f32x16{}; p1 = f32x16{};
#pragma unroll
    for (int d0 = 0; d0 < 8; ++d0) { int cb = (d0 * 16 + hi * 8) * 2;
        bf16x8 b0 = *reinterpret_cast<const bf16x8*>((const char*)Ks + KSWZ(r32, cb));
        bf16x8 b1 = *reinterpret_cast<const bf16x8*>((const char*)Ks + KSWZ(32 + r32, cb));
        p0 = __builtin_amdgcn_mfma_f32_32x32x16_bf16(b0, qr[d0], p0, 0, 0, 0);
        p1 = __builtin_amdgcn_mfma_f32_32x32x16_bf16(b1, qr[d0], p1, 0, 0, 0); }
}
__device__ __forceinline__ int v_st(int k, int c) { const int kk = (k & ~0xC) | ((k & 4) << 1) | ((k & 8) >> 1); return ((kk >> 3) * 4 + (c >> 5)) * 512 + ((kk & 7) * 32 + (c & 31)) * 2; }
__device__ __forceinline__ int v_rd_base(int lane) { return ((lane & 3) << 3) | (((lane >> 2) & 3) << 6) | (((lane >> 4) & 1) << 5) | (((lane >> 5) & 1) << 8); }
constexpr int v_rd_off(int d0, int ks, int half) { return d0 * 512 + ks * 4096 + half * 2048; }
template <int OFF> __device__ __forceinline__ s16x4 tr_read(int vb) {
    s16x4 r; asm volatile("ds_read_b64_tr_b16 %0, %1 offset:%2" : "=&v"(r) : "v"(vb), "i"(OFF) : "memory"); return r;
}
template <int D0> __device__ __forceinline__ void pv_one(f32x16& od, int vb, bf16x8 pa0, bf16x8 pa1, bf16x8 pa2, bf16x8 pa3) {
    const s16x4 l0 = tr_read<v_rd_off(D0, 0, 0)>(vb), h0 = tr_read<v_rd_off(D0, 0, 1)>(vb), l1 = tr_read<v_rd_off(D0, 1, 0)>(vb), h1 = tr_read<v_rd_off(D0, 1, 1)>(vb);
    const s16x4 l2 = tr_read<v_rd_off(D0, 2, 0)>(vb), h2 = tr_read<v_rd_off(D0, 2, 1)>(vb), l3 = tr_read<v_rd_off(D0, 3, 0)>(vb), h3 = tr_read<v_rd_off(D0, 3, 1)>(vb);
    asm volatile("s_waitcnt lgkmcnt(0)" ::: "memory"); SBAR();
#define PK(L, H) (bf16x8){L[0], L[1], L[2], L[3], H[0], H[1], H[2], H[3]}
    od = __builtin_amdgcn_mfma_f32_32x32x16_bf16(pa0, PK(l0, h0), od, 0, 0, 0);
    od = __builtin_amdgcn_mfma_f32_32x32x16_bf16(pa1, PK(l1, h1), od, 0, 0, 0);
    od = __builtin_amdgcn_mfma_f32_32x32x16_bf16(pa2, PK(l2, h2), od, 0, 0, 0);
    od = __builtin_amdgcn_mfma_f32_32x32x16_bf16(pa3, PK(l3, h3), od, 0, 0, 0);
#undef PK
}
__device__ __forceinline__ void pv_d0(f32x16* o, int vb, bf16x8 pa0, bf16x8 pa1, bf16x8 pa2, bf16x8 pa3) {
    pv_one<0>(o[0], vb, pa0, pa1, pa2, pa3); pv_one<1>(o[1], vb, pa0, pa1, pa2, pa3); pv_one<2>(o[2], vb, pa0, pa1, pa2, pa3); pv_one<3>(o[3], vb, pa0, pa1, pa2, pa3);
}
__device__ __forceinline__ void attn_dense_body(const int wv, const bf16_t* __restrict__ Qb, const bf16_t* __restrict__ Kh, const bf16_t* __restrict__ Vh,
                                                bf16_t* __restrict__ Ob, int seq, char* lds) {
    const int tid = ltid(wv), wid = tid >> 6, lane = tid & 63, r32 = lane & 31, hi = lane >> 5;
    bf16_t* V_lds = (bf16_t*)lds; bf16_t* K_lds = (bf16_t*)(lds + 2 * SHM_V);
    float* ws = (float*)(lds + 2 * SHM_V + 2 * SHM_K) + wid * 64; float* li_l = ws; float* al_l = ws + 32;
    float m_reg = -1e30f, l_reg = 0; f32x16 o[4] = {}; bf16x8 qr[8];
    const bf16_t* Qw = Qb + (long)(wid * QBLK + r32) * LDQ + hi * 8;
#pragma unroll
    for (int d0 = 0; d0 < 8; ++d0) qr[d0] = *reinterpret_cast<const bf16x8*>(Qw + d0 * 16);
    const int sr = tid >> 4, sc = (tid & 15) * 8, vst0 = v_st(sr, sc), vst1 = v_st(32 + sr, sc);
    const int vb0 = (int)(uintptr_t)V_lds + v_rd_base(lane);
    struct { bf16x8 vs0, vs1, ks0, ks1; } sr_[2];
#define SLOAD(i, k0) do { sr_[i].vs0 = *reinterpret_cast<const bf16x8*>(&Vh[(long)((k0) + sr) * LDK + sc]); sr_[i].vs1 = *reinterpret_cast<const bf16x8*>(&Vh[(long)((k0) + 32 + sr) * LDK + sc]); \
    sr_[i].ks0 = *reinterpret_cast<const bf16x8*>(&Kh[(long)((k0) + sr) * LDK + sc]); sr_[i].ks1 = *reinterpret_cast<const bf16x8*>(&Kh[(long)((k0) + 32 + sr) * LDK + sc]); } while (0)
#define SWRITE(b, i) do { *(bf16x8*)((char*)V_lds + (b) * SHM_V + vst0) = sr_[i].vs0;          \
    *(bf16x8*)((char*)V_lds + (b) * SHM_V + vst1) = sr_[i].vs1; int kc = sc * 2;               \
    *(bf16x8*)((char*)K_lds + (b) * SHM_K + KSWZ(sr, kc)) = sr_[i].ks0;                       \
    *(bf16x8*)((char*)K_lds + (b) * SHM_K + KSWZ(32 + sr, kc)) = sr_[i].ks1; } while (0)
#define SWAIT() asm volatile("s_waitcnt vmcnt(4)" ::: "memory")
#define RESC(a) do { if (__any((a) < 1.f)) { if (hi == 0) al_l[r32] = (a); asm volatile("s_waitcnt lgkmcnt(0)" ::: "memory"); \
    _Pragma("unroll") for (int d = 0; d < 4; ++d) _Pragma("unroll") for (int r = 0; r < 16; ++r) o[d][r] *= al_l[crow(r, hi)]; } } while (0)
    f32x16 pA0, pA1, pB0, pB1; float mnA, mnB, alA, alB; bf16x8 pa0, pa1, pa2, pa3; const int NT = seq / KVBLK;
    constexpr int SE = 0, SO = 1;
    SLOAD(SE, 0); asm volatile("s_waitcnt vmcnt(0)" ::: "memory"); SWRITE(0, SE); __syncthreads();
    qkt(pA0, pA1, K_lds, qr, r32, hi); partialSM(pA0, pA1, m_reg, mnA, alA);
    SLOAD(SO, KVBLK); if (2 < NT) SLOAD(SE, 2 * KVBLK);
    SWAIT(); SWRITE(1, SO); __syncthreads();
    for (int j = 1; j + 1 < NT; j += 2) {
        SBAR(); qkt(pB0, pB1, (bf16_t*)((char*)K_lds + SHM_K), qr, r32, hi);
        finishSM(pA0, pA1, alA, l_reg, pa0, pa1, pa2, pa3); SBAR();
        SLOAD(SO, (j + 2) * KVBLK); SBAR();
        pv_d0(o, vb0, pa0, pa1, pa2, pa3); partialSM(pB0, pB1, m_reg, mnB, alB);
        __syncthreads(); SWAIT(); SWRITE(0, SE);
        RESC(alB); __syncthreads();
        SBAR(); qkt(pA0, pA1, K_lds, qr, r32, hi);
        finishSM(pB0, pB1, alB, l_reg, pa0, pa1, pa2, pa3); SBAR();
        if (j + 3 < NT) SLOAD(SE, (j + 3) * KVBLK); SBAR();
        pv_d0(o, vb0 + (int)SHM_V, pa0, pa1, pa2, pa3); partialSM(pA0, pA1, m_reg, mnA, alA);
        __syncthreads(); SWAIT(); SWRITE(1, SO);
        RESC(alA); __syncthreads();
    }
    SBAR(); qkt(pB0, pB1, (bf16_t*)((char*)K_lds + SHM_K), qr, r32, hi);
    finishSM(pA0, pA1, alA, l_reg, pa0, pa1, pa2, pa3); SBAR();
    pv_d0(o, vb0, pa0, pa1, pa2, pa3); partialSM(pB0, pB1, m_reg, mnB, alB);
    __syncthreads(); RESC(alB);
    finishSM(pB0, pB1, alB, l_reg, pa0, pa1, pa2, pa3); SBAR();
    pv_d0(o, vb0 + (int)SHM_V, pa0, pa1, pa2, pa3);
    if (hi == 0) li_l[r32] = l_reg; asm volatile("s_waitcnt lgkmcnt(0)" ::: "memory");
    float rli[16];
#pragma unroll
    for (int r = 0; r < 16; ++r) rli[r] = __builtin_amdgcn_rcpf(li_l[crow(r, hi)]);
    bf16_t* Ow = Ob + (long)(wid * QBLK) * LDO;
#pragma unroll
    for (int r = 0; r < 16; ++r) { int orow = crow(r, hi);
#pragma unroll
        for (int d0 = 0; d0 < 4; ++d0) Ow[(long)orow * LDO + d0 * 32 + r32] = f2bf(o[d0][r] * rli[r]); }
#undef SLOAD
#undef SWRITE
#undef SWAIT
#undef RESC
}
}

template <bool FW = false>
__device__ __forceinline__ void tr_job(const int wv, const float* __restrict__ src, bf16_t* __restrict__ dst, int K, int N, float* t, int& off) {
    const int G = gridDim.x, tid = ltid(wv); const int tn = N / 64, ntiles = (K / 64) * tn;
    int first = ((int)blockIdx.x - (off % G) + G) % G;
    for (int tile = first; tile < ntiles; tile += G) {
        const int k0 = (tile / tn) * 64, n0 = (tile % tn) * 64;
        { const int kk = tid >> 4, c4 = (tid & 15) * 4;
#pragma unroll
          for (int h = 0; h < 2; ++h) { f32x4 v;
              if (!FW) v = *(const f32x4*)(src + (size_t)(k0 + kk + h * 32) * N + n0 + c4);
              else { const int n = k0 + kk + h * 32; int r1, r2; float s2 = 1.f;
                  if (n < 512) { const int g = n >> 6, l = n & 63; r1 = g * 128 + l; r2 = l ? g * 128 + 128 - l : -1; }
                  else if (n < 520) { r1 = (n - 512) * 128 + 64; r2 = -1; }
                  else { const int q = n - 520; const int g = q / 63, l = q - g * 63 + 1; r1 = g * 128 + 128 - l; r2 = g * 128 + l; s2 = -1.f; }
                  v = *(const f32x4*)(src + (size_t)r1 * N + n0 + c4);
                  if (r2 >= 0) v += *(const f32x4*)(src + (size_t)r2 * N + n0 + c4) * s2; }
              float* tp = t + (kk + h * 32) * 65 + c4; tp[0] = v[0]; tp[1] = v[1]; tp[2] = v[2]; tp[3] = v[3]; } }
        __syncthreads();
        { const int nn = tid >> 3, kc = (tid & 7) * 8; float v[8];
#pragma unroll
          for (int j = 0; j < 8; ++j) v[j] = t[(kc + j) * 65 + nn];
          u32x4 w = {cvtpk(v[0], v[1]), cvtpk(v[2], v[3]), cvtpk(v[4], v[5]), cvtpk(v[6], v[7])};
          *(u32x4*)(dst + (size_t)(n0 + nn) * K + k0 + kc) = w; }
        __syncthreads();
    }
    off += ntiles;
}

typedef const __attribute__((address_space(4))) Params* PP;
__device__ __forceinline__ void prep_phase(const int wv, PP p, char* lds) {
    const int tid = ltid(wv), lane = tid & 63, wid = tid >> 6, G = gridDim.x, bid = blockIdx.x;
    unsigned char* ws = p->ws;
    {
        float* sT = (float*)lds; float* red = (float*)(lds + 81920);
        for (int idx = tid; idx < 20 * 1024; idx += 512) { const int r = idx >> 10, k = idx & 1023; float v = 0.f;
            if (r < 17) { const float cv = r < 16 ? p->c[r * 1024 + k] : p->c_ctx[k]; v = cv / (1.f + __expf(-cv)); }
            sT[k * 20 + r] = v; }
        __syncthreads();
        for (int task = bid; task < 192; task += G) {
            const int layer = task / 48, chunk = task % 48; const int colw = tid & 127, kg = tid >> 7, n = chunk * 128 + colw;
            float acc[17];
#pragma unroll
            for (int r = 0; r < 17; ++r) acc[r] = 0.f;
            const float* wp = p->ada_w + ((size_t)layer * 1024 + kg * 256) * 6144 + n;
#pragma unroll 16
            for (int k = 0; k < 256; ++k) { const float w = wp[(size_t)k * 6144]; const float* sp = sT + (kg * 256 + k) * 20;
                const f32x4 s0 = *(const f32x4*)sp, s1 = *(const f32x4*)(sp + 4), s2 = *(const f32x4*)(sp + 8), s3 = *(const f32x4*)(sp + 12); const float s16 = sp[16];
#pragma unroll
                for (int j = 0; j < 4; ++j) { acc[j] += s0[j] * w; acc[4 + j] += s1[j] * w; acc[8 + j] += s2[j] * w; acc[12 + j] += s3[j] * w; }
                acc[16] += s16 * w; }
#pragma unroll
            for (int r = 0; r < 17; ++r) red[(kg * 17 + r) * 128 + colw] = acc[r];
            __syncthreads();
            for (int idx = tid; idx < 17 * 128; idx += 512) { const int r = idx >> 7, cw = idx & 127; const int nn = chunk * 128 + cw;
                const float s = red[(0 * 17 + r) * 128 + cw] + red[(1 * 17 + r) * 128 + cw] + red[(2 * 17 + r) * 128 + cw] + red[(3 * 17 + r) * 128 + cw] + p->ada_b[layer * 6144 + nn];
                ((float*)(ws + O_MOD))[((size_t)layer * 17 + r) * 6144 + nn] = s; }
            __syncthreads();
        }
        __syncthreads();
    }
    {
        float* t = (float*)lds; int off = 0;
        for (int l = 0; l < 4; ++l) {
            tr_job(wv, p->mlp_w1 + (size_t)l * 1024 * 4096, (bf16_t*)(ws + O_W1T) + (size_t)l * 4096 * 1024, 1024, 4096, t, off);
            tr_job(wv, p->mlp_w2 + (size_t)l * 4096 * 1024, (bf16_t*)(ws + O_W2T) + (size_t)l * 1024 * 4096, 4096, 1024, t, off);
        }
        for (int j = 0; j < 2; ++j) tr_job<true>(wv, p->fnet_w_out + (size_t)j * 1024 * 1024, (bf16_t*)(ws + O_FWOT) + (size_t)j * 1024 * 1024, 1024, 1024, t, off);
        tr_job(wv, p->attn_w_qkv, (bf16_t*)(ws + O_WQKVT), 1024, 1536, t, off);
        tr_job(wv, p->attn_w_o, (bf16_t*)(ws + O_WOT), 1024, 1024, t, off);
        tr_job(wv, p->lru_w_in, (bf16_t*)(ws + O_LWINT), 1024, 2560, t, off);
        tr_job(wv, p->lru_w_out, (bf16_t*)(ws + O_LWOT), 1280, 1024, t, off);
    }
    {
        float* wt = (float*)lds; float* tab = (float*)(lds + 64 * 129 * 4);
        for (int task = bid; task < 256; task += G) {
            const int j = task >> 7, g = (task >> 4) & 7, k0 = (task & 15) * 64;
            if (tid < 128) tab[tid] = cospif((float)tid * (1.f / 64.f));
#pragma unroll
            for (int i = 0; i < 4; ++i) { const int idx = tid + i * 512; const int row = idx >> 5, c4 = (idx & 31) * 4;
                const f32x4 v = *(const f32x4*)(p->fnet_w_in + ((size_t)j * 1024 + k0 + row) * 1024 + g * 128 + c4); float* tp = wt + row * 129 + c4; tp[0] = v[0]; tp[1] = v[1]; tp[2] = v[2]; tp[3] = v[3]; }
            __syncthreads();
            bf16_t* dstb = (bf16_t*)(ws + O_WPQT) + (size_t)j * 1024 * 1024;
            for (int ii = 0; ii < 16; ++ii) { const int i = wid * 16 + ii; const int sf = i > 64 ? 1 : 0; const int l = sf ? i - 64 : i;
                const int n = sf ? 520 + g * 63 + l - 1 : (l < 64 ? g * 64 + l : 512 + g);
                float acc = 0.f; const float* wr_ = wt + lane * 129;
#pragma unroll 8
                for (int c = 0; c < 128; ++c) acc += wr_[c] * tab[(l * c - sf * 32) & 127];
                dstb[(size_t)n * 1024 + k0 + lane] = f2bf(acc); }
            __syncthreads();
        }
    }
    { float* gp = (float*)(ws + O_GPAR); for (int i = bid * 512 + tid; i < 2 * DRNN; i += G * 512) { const int d = i / DRNN, c = i - d * DRNN;
        gp[(d * 3 + 0) * DRNN + c] = p->ga_b[i] * -1.4426950408889634f; gp[(d * 3 + 1) * DRNN + c] = p->gx_b[i] * -1.4426950408889634f; gp[(d * 3 + 2) * DRNN + c] = -8.f * __logf(1.f + __expf(-p->lam[i])); } }
    { float* rt = (float*)(ws + O_ROPE); for (int i = bid * 512 + tid; i < 2048; i += G * 512) { const int pos = i >> 5, j = i & 31; const float inv = powf(10000.f, -(float)j * (1.f / 32.f)); float sn, cs; sincosf((float)pos * inv, &sn, &cs); rt[i * 2] = cs; rt[i * 2 + 1] = sn; } }
    {
        bf16_t* gt = (bf16_t*)(ws + O_GATET);
        for (int idx = bid * 512 + tid; idx < 2 * 2560 * 256; idx += G * 512) {
            const int d = idx / (2560 * 256); const int rem = idx - d * 2560 * 256; const int n = rem >> 8, k = rem & 255;
            const int blk = n >> 8, half = (n >> 7) & 1, jout = n & 127, kq = k >> 7, i = k & 127; float v = 0.f;
            if (kq == (blk & 1)) v = (half ? p->gx_w : p->ga_w)[(((size_t)d * 10 + blk) * 128 + i) * 128 + jout];
            gt[idx] = f2bf(v); }
    }
    {
        bf16_t* d2 = (bf16_t*)(ws + O_D256);
        for (int idx = bid * 512 + tid; idx < 512 * 256; idx += G * 512) { const int r = idx >> 8, t = idx & 255; const float a = (float)(((r & 255) * t) & 255) * (1.f / 128.f);
            d2[idx] = f2bf(r < 256 ? cospif(a) : sinpif(a)); }
    }
}

__device__ __forceinline__ void dmat_gen(const int wv, bf16_t* dm, char* lds) {
    float* tab = (float*)lds; const int tid = ltid(wv);
    for (int i = tid; i < 4096; i += 512) tab[i] = cospif((float)i * (1.f / 2048.f));
    __syncthreads();
    constexpr int VR = KF / 8;
    for (int idx = blockIdx.x * 512 + tid; idx < 4096 * VR; idx += gridDim.x * 512) { const int row = idx / VR, v = idx - row * VR; const int type = row >> 11, cls = (row >> 10) & 1, k = 2 * (row & 1023) + cls; const int t0 = v * 8; const int sh = type ? 3072 : 0;
        float f[8];
#pragma unroll
        for (int e = 0; e < 8; ++e) f[e] = (t0 + e <= 1024) ? tab[(k * (t0 + e) + sh) & 4095] : 0.f;
        u32x4 w = {cvtpk(f[0], f[1]), cvtpk(f[2], f[3]), cvtpk(f[4], f[5]), cvtpk(f[6], f[7])};
        *(u32x4*)(dm + (size_t)idx * 8) = w; }
    __syncthreads();
}
__device__ __forceinline__ void fold_phase(const int wv, const bf16_t* __restrict__ src, bf16_t* __restrict__ dst) {
    const int tid = ltid(wv); const int lane = tid & 63, wid = tid >> 6; const int gwv = blockIdx.x * 8 + wid, nwv = gridDim.x * 8;
    for (int r = gwv; r < 16640; r += nwv) { const bf16_t* rp = src + (size_t)r * 4096; bf16_t* wE = dst + (size_t)r * KF; bf16_t* wO = dst + (size_t)(16640 + r) * KF;
        const bool isq = (r >= 8192 && r < 16384); const float sg = isq ? -1.f : 1.f;
        u32x4 a1[2], a2[2], g1[2], h1[2]; bf16_t gx[2], hx[2];
#pragma unroll
        for (int i = 0; i < 2; ++i) { const int t0 = i * 512 + lane * 8; a1[i] = *(const u32x4*)(rp + t0); a2[i] = *(const u32x4*)(rp + 2048 + t0); g1[i] = *(const u32x4*)(rp + 2040 - t0); h1[i] = *(const u32x4*)(rp + 4088 - t0);
            gx[i] = rp[2048 - t0]; hx[i] = rp[t0 ? 4096 - t0 : 0]; }
        const float x1024 = bf1(rp[1024]) + sg * bf1(rp[3072]);
#pragma unroll
        for (int i = 0; i < 2; ++i) { const int t0 = i * 512 + lane * 8;
#define UNPK(W) {bflo(W[0]), bfhi(W[0]), bflo(W[1]), bfhi(W[1]), bflo(W[2]), bfhi(W[2]), bflo(W[3]), bfhi(W[3])}
            const float xa[8] = UNPK(a1[i]); const float xb2[8] = UNPK(a2[i]); const float yg[8] = UNPK(g1[i]); const float yh[8] = UNPK(h1[i]);
#undef UNPK
            float oe[8], oo[8];
#pragma unroll
            for (int e = 0; e < 8; ++e) { const bool t_is0 = (e == 0) && (t0 == 0);
                const float p_t = xa[e], p_2048pt = t_is0 ? 0.f : xb2[e];
                const float p_2048mt = e ? yg[8 - e] : bf1(gx[i]);
                const float p_4096mt = t_is0 ? 0.f : (e ? yh[8 - e] : bf1(hx[i]));
                const float s1 = p_t + sg * p_4096mt, s2 = p_2048mt + sg * p_2048pt;
                oe[e] = s1 + sg * s2; oo[e] = s1 - sg * s2; }
            const u32x4 we = {cvtpk(oe[0], oe[1]), cvtpk(oe[2], oe[3]), cvtpk(oe[4], oe[5]), cvtpk(oe[6], oe[7])};
            const u32x4 wo = {cvtpk(oo[0], oo[1]), cvtpk(oo[2], oo[3]), cvtpk(oo[4], oo[5]), cvtpk(oo[6], oo[7])};
            *(u32x4*)(wE + t0) = we; *(u32x4*)(wO + t0) = wo; }
        const unsigned x16 = cvtpk(x1024, 0.f) & 0xffffu;
        *(unsigned*)(wE + 1024 + lane * 2) = (lane == 0 && !isq) ? x16 : 0u;
        *(unsigned*)(wO + 1024 + lane * 2) = (lane == 0 && isq) ? x16 : 0u;
    }
}
__device__ __forceinline__ void nyquist_pass(const int wv, const bf16_t* PP, const bf16_t* P64, bf16_t* F, float scale) {
    const int tid = ltid(wv); const int lane = tid & 63, wid = tid >> 6; const int gwv = blockIdx.x * 8 + wid, nwv = gridDim.x * 8;
    for (int r = gwv; r < 8192 + 128; r += nwv) { const bf16_t* src; int b, n;
        if (r < 8192) { src = PP + (size_t)r * 4096; b = r >> 9; n = r & 511; } else { const int rr = r - 8192; src = P64 + (size_t)rr * 4096; b = rr >> 3; n = 512 + (rr & 7); }
        float sacc = 0.f;
#pragma unroll
        for (int i = 0; i < 8; ++i) { const u32x4 w = *(const u32x4*)(src + i * 512 + lane * 8);
            sacc += (bflo(w[0]) - bfhi(w[0])) + (bflo(w[1]) - bfhi(w[1])) + (bflo(w[2]) - bfhi(w[2])) + (bflo(w[3]) - bfhi(w[3])); }
        sacc = wave_sum(sacc, lane);
        if (lane == 0) F[((size_t)b * 4096 + 2048) * 1024 + n] = f2bf(sacc * scale); }
    for (int idx = blockIdx.x * 512 + tid; idx < 16 * 504; idx += gridDim.x * 512) { const int b = idx / 504, q = idx - b * 504; F[((size_t)b * 4096 + 2048) * 1024 + 520 + q] = 0; }
}

template <bool F32IN>
__device__ __forceinline__ void norm_phase(const int wv, const float* __restrict__ xl, const float* __restrict__ xc, bf16_t* xb, const float* __restrict__ gw, const float* __restrict__ mod, int shoff, int scoff, bf16_t* __restrict__ H, int nrows,
                                           const float* __restrict__ part = nullptr, const float* __restrict__ pgate = nullptr) {
    const int tid = ltid(wv); const int lane = tid & 63, wid = tid >> 6; const int gwv = blockIdx.x * 8 + wid, nwv = gridDim.x * 8; const int ntask = nrows / 8;
    for (int task = gwv; task < ntask; task += nwv) {
        const int row0 = task * 8; const int bidx = row0 < NLAT ? (row0 >> 12) : 16; const float* mrow = mod + bidx * 6144;
        const float* src0 = (row0 < NLAT ? xl + (size_t)row0 * 1024 : xc + (size_t)(row0 - NLAT) * 1024) + lane * 4;
        bf16_t* xr0 = xb + (size_t)row0 * 1024 + lane * 4;
        f32x4 mul[4], add[4];
#pragma unroll
        for (int j = 0; j < 4; ++j) { const int col = j * 256 + lane * 4; const f32x4 g4 = *(const f32x4*)(gw + col), sc4 = *(const f32x4*)(mrow + scoff + col); add[j] = *(const f32x4*)(mrow + shoff + col); mul[j] = g4 * (sc4 + 1.f); }
#pragma unroll
        for (int hb = 0; hb < 2; ++hb) {
            f32x4 v[4][4];
            if (F32IN) {
#pragma unroll
                for (int r = 0; r < 4; ++r)
#pragma unroll
                    for (int j = 0; j < 4; ++j) v[r][j] = *(const f32x4*)(src0 + (size_t)(hb * 4 + r) * 1024 + j * 256);
                __builtin_amdgcn_sched_barrier(0);
#pragma unroll
                for (int r = 0; r < 4; ++r)
#pragma unroll
                    for (int j = 0; j < 4; ++j) st_bf4(xr0 + (size_t)(hb * 4 + r) * 1024 + j * 256, v[r][j]);
            } else {
                u32x2 w[4][4];
#pragma unroll
                for (int r = 0; r < 4; ++r)
#pragma unroll
                    for (int j = 0; j < 4; ++j) w[r][j] = *(const u32x2*)(xr0 + (size_t)(hb * 4 + r) * 1024 + j * 256);
                __builtin_amdgcn_sched_barrier(0);
#pragma unroll
                for (int r = 0; r < 4; ++r)
#pragma unroll
                    for (int j = 0; j < 4; ++j) v[r][j] = (f32x4){bflo(w[r][j][0]), bfhi(w[r][j][0]), bflo(w[r][j][1]), bfhi(w[r][j][1])};
            }
            if (part && row0 >= NLAT) {
#pragma unroll
                for (int r = 0; r < 4; ++r) { const size_t o = (size_t)(row0 - NLAT + hb * 4 + r) * 1024 + lane * 4;
#pragma unroll
                    for (int j = 0; j < 4; ++j) { const f32x4 g4 = *(const f32x4*)(pgate + j * 256 + lane * 4);
                        const f32x4 p0 = *(const f32x4*)(part + o + j * 256), p1 = *(const f32x4*)(part + (size_t)NCTX * 1024 + o + j * 256), p2 = *(const f32x4*)(part + (size_t)2 * NCTX * 1024 + o + j * 256), p3 = *(const f32x4*)(part + (size_t)3 * NCTX * 1024 + o + j * 256);
                        v[r][j] += g4 * ((p0 + p1) + (p2 + p3)); st_bf4(xr0 + (size_t)(hb * 4 + r) * 1024 + j * 256, v[r][j]); } }
                __builtin_amdgcn_sched_barrier(0); }
#pragma unroll
            for (int r = 0; r < 4; ++r) { float ss = 0.f;
#pragma unroll
                for (int j = 0; j < 4; ++j) ss += v[r][j][0] * v[r][j][0] + v[r][j][1] * v[r][j][1] + v[r][j][2] * v[r][j][2] + v[r][j][3] * v[r][j][3];
                ss = wave_sum(ss, lane); const float rstd = rsqrtf(ss * (1.f / 1024.f) + 1e-6f);
#pragma unroll
                for (int j = 0; j < 4; ++j) st_bf4(H + (size_t)(row0 + hb * 4 + r) * 1024 + j * 256 + lane * 4, v[r][j] * rstd * mul[j] + add[j]); }
            __builtin_amdgcn_sched_barrier(0);
        }
    }
}

__device__ __forceinline__ void final_phase(const int wv, const bf16_t* __restrict__ xb, float* __restrict__ out, const float* __restrict__ gw) {
    const int tid = ltid(wv); const int lane = tid & 63, wid = tid >> 6; const int gwv = blockIdx.x * 8 + wid, nwv = gridDim.x * 8;
    f32x4 g4[4];
#pragma unroll
    for (int j = 0; j < 4; ++j) g4[j] = *(const f32x4*)(gw + j * 256 + lane * 4);
    for (int task = gwv; task < NLAT / 4; task += nwv) { const bf16_t* src = xb + (size_t)task * 4 * 1024 + lane * 4; float* dst = out + (size_t)task * 4 * 1024 + lane * 4; u32x2 w[4][4];
#pragma unroll
        for (int r = 0; r < 4; ++r)
#pragma unroll
            for (int j = 0; j < 4; ++j) w[r][j] = *(const u32x2*)(src + (size_t)r * 1024 + j * 256);
        __builtin_amdgcn_sched_barrier(0);
#pragma unroll
        for (int r = 0; r < 4; ++r) { f32x4 v[4]; float ss = 0.f;
#pragma unroll
            for (int j = 0; j < 4; ++j) { v[j] = (f32x4){bflo(w[r][j][0]), bfhi(w[r][j][0]), bflo(w[r][j][1]), bfhi(w[r][j][1])}; ss += v[j][0] * v[j][0] + v[j][1] * v[j][1] + v[j][2] * v[j][2] + v[j][3] * v[j][3]; }
            ss = wave_sum(ss, lane); const float rstd = rsqrtf(ss * (1.f / 1024.f) + 1e-6f);
#pragma unroll
            for (int j = 0; j < 4; ++j) *(f32x4*)(dst + (size_t)r * 1024 + j * 256) = v[j] * rstd * g4[j]; }
        __builtin_amdgcn_sched_barrier(0); }
}

__device__ __forceinline__ void qknorm_phase(const int wv, const bf16_t* raw, bf16_t* Q, bf16_t* KB, bf16_t* VB, const float* qg, const float* kg, char* lds) {
    float* ctab = (float*)lds; float* stab = ctab + 2048; const int tid = ltid(wv), lane = tid & 63, wid = tid >> 6;
    for (int i = tid; i < 2048; i += 512) { const int pos = i >> 5, j = i & 31; const float inv = powf(10000.f, -(float)j * (1.f / 32.f)); const float ang = (float)pos * inv; float s, c; sincosf(ang, &s, &c); ctab[i] = c; stab[i] = s; }
    __syncthreads();
    const int gwv = blockIdx.x * 8 + wid, nwv = gridDim.x * 8; const int l16 = lane & 15; const int nwt = NTOK * 12 / 4;
    for (int wt0 = gwv * 4; wt0 < nwt; wt0 += nwv * 4) {
        u32x4 wv[4];
#pragma unroll
        for (int q = 0; q < 4; ++q) { const int tk = (wt0 + q) * 4 + (lane >> 4); const int row = tk / 12, hs = tk - row * 12; wv[q] = *(const u32x4*)(raw + (size_t)row * 1536 + hs * 128 + l16 * 8); }
        __builtin_amdgcn_sched_barrier(0);
#pragma unroll
        for (int q = 0; q < 4; ++q) {
            const int tk = (wt0 + q) * 4 + (lane >> 4); const int row = tk / 12, hs = tk - row * 12; const u32x4 w = wv[q];
            float y[8] = {bflo(w[0]), bfhi(w[0]), bflo(w[1]), bfhi(w[1]), bflo(w[2]), bfhi(w[2]), bflo(w[3]), bfhi(w[3])};
            float ss = 0.f;
#pragma unroll
            for (int e = 0; e < 8; ++e) ss += y[e] * y[e];
            ss += lane_xor(ss, lane, 1); ss += lane_xor(ss, lane, 2); ss += lane_xor(ss, lane, 4); ss += lane_xor(ss, lane, 8);
            int krow;
            if (row < NLAT) krow = (row >> 12) * SKV + (row & 4095); else { const int rc = row - NLAT; krow = (rc >> 8) * SKV + SEQ + (rc & 255); }
            if (hs < 10) {
                const float rstd = rsqrtf(ss * (1.f / 128.f) + 1e-6f); const float* gp = (hs < 8 ? qg : kg) + l16 * 8;
#pragma unroll
                for (int e = 0; e < 8; ++e) y[e] = y[e] * rstd * gp[e];
                if (row < NLAT) { const int t = row & 4095, ri = t >> 6, ci = t & 63;
#pragma unroll
                    for (int pp = 0; pp < 4; ++pp) { const int i = l16 * 4 + pp; const int pos = i < 32 ? ri : ci; const int j = i & 31; const float cs = ctab[pos * 32 + j], sn = stab[pos * 32 + j];
                        const float y0 = y[2 * pp], y1 = y[2 * pp + 1]; y[2 * pp] = y0 * cs - y1 * sn; y[2 * pp + 1] = y0 * sn + y1 * cs; } }
                const u32x4 o = {cvtpk(y[0], y[1]), cvtpk(y[2], y[3]), cvtpk(y[4], y[5]), cvtpk(y[6], y[7])};
                if (hs < 8) *(u32x4*)(Q + (size_t)row * 1024 + hs * 128 + l16 * 8) = o;
                else *(u32x4*)(KB + (size_t)krow * 256 + (hs - 8) * 128 + l16 * 8) = o;
            } else *(u32x4*)(VB + (size_t)krow * 256 + (hs - 10) * 128 + l16 * 8) = w;
        }
        __builtin_amdgcn_sched_barrier(0);
    }
    __syncthreads();
}

__device__ __forceinline__ void attn_phase(const int wv, const bf16_t* Q, const bf16_t* KB, const bf16_t* VB, bf16_t* O, char* lds) {
    const int G = gridDim.x;
    for (int u = blockIdx.x; u < 2048 + 128; u += G) {
        if (u < 2048) {
            int qb, gh;
            if (G == 256) { const int w = u & 255, rnd = u >> 8; const int xcd = w & 7, slot = w >> 3; gh = rnd * 16 + 2 * xcd + (slot >> 4); qb = slot & 15; }
            else { qb = u & 15; gh = u >> 4; }
            const int h = gh & 7, b = gh >> 3; const int kvh = h >> 2;
            const size_t q0 = ((size_t)b * SEQ + qb * 256) * 1024 + h * 128; const size_t k0 = (size_t)b * SKV * 256 + kvh * 128;
            at::attn_dense_body(wv, Q + q0, KB + k0, VB + k0, O + q0, SKV, lds);
        } else { const int v = u - 2048; const int h = v & 7, b = v >> 3; const int kvh = h >> 2;
            const size_t q0 = ((size_t)NLAT + b * 256) * 1024 + h * 128; const size_t k0 = ((size_t)b * SKV + SEQ) * 256 + kvh * 128;
            at::attn_dense_body(wv, Q + q0, KB + k0, VB + k0, O + q0, TCTX, lds); }
        __syncthreads();
    }
}

__device__ __forceinline__ void conv_phase(const int wv, const bf16_t* __restrict__ XR, bf16_t* __restrict__ XC, const float* __restrict__ cw, const float* __restrict__ cb) {
    const int total = (NTOK / 8) * 160; const int tid_ = ltid(wv);
    for (int idx = blockIdx.x * 512 + tid_; idx < total; idx += gridDim.x * 512) {
        const int rb = idx / 160, v = idx - rb * 160, ch0 = v * 8, row0 = rb * 8; int t0, T;
        if (row0 < NLAT) { t0 = row0 & 4095; T = SEQ; } else { t0 = (row0 - NLAT) & 255; T = TCTX; }
        u32x4 xw[11];
#pragma unroll
        for (int i = 0; i < 11; ++i) { const int tt = t0 + i - 2; xw[i] = (tt >= 0 && tt < T) ? *(const u32x4*)(XR + (size_t)(row0 + i - 2) * DRNN + ch0) : (u32x4){0u, 0u, 0u, 0u}; }
        f32x4 wk[4][2], bb[2];
#pragma unroll
        for (int k = 0; k < 4; ++k) { wk[k][0] = *(const f32x4*)(cw + k * DRNN + ch0); wk[k][1] = *(const f32x4*)(cw + k * DRNN + ch0 + 4); }
        bb[0] = *(const f32x4*)(cb + ch0); bb[1] = *(const f32x4*)(cb + ch0 + 4);
        __builtin_amdgcn_sched_barrier(0);
#pragma unroll
        for (int r = 0; r < 8; ++r) { f32x4 a0 = bb[0], a1 = bb[1];
#pragma unroll
            for (int k = 0; k < 4; ++k) { const u32x4 w = xw[r + k];
                a0 += wk[k][0] * (f32x4){bflo(w[0]), bfhi(w[0]), bflo(w[1]), bfhi(w[1])}; a1 += wk[k][1] * (f32x4){bflo(w[2]), bfhi(w[2]), bflo(w[3]), bfhi(w[3])}; }
            const u32x4 o = {cvtpk(a0[0], a0[1]), cvtpk(a0[2], a0[3]), cvtpk(a1[0], a1[1]), cvtpk(a1[2], a1[3])};
            *(u32x4*)(XC + (size_t)(row0 + r) * DRNN + ch0) = o; }
    }
}

__device__ __forceinline__ void scan_phase(const int wv, int dir, const bf16_t* LA, const bf16_t* U, bf16_t* R, bf16_t* Gb, char* lds) {
    float* sA = (float*)lds; float* sH = sA + 512; const int tid = ltid(wv), lane = tid & 63, wid = tid >> 6;
    constexpr int CH = SKV / 8;
    for (int task = blockIdx.x; task < NBATCH * 20; task += gridDim.x) {
        const int b = task / 20, cgp = task - b * 20; const int ch = cgp * 64 + lane;
        const int s_begin = wid * CH;
        float sumla = 0.f, hh = 0.f;
        for (int s0 = s_begin; s0 < s_begin + CH; s0 += 16) {
            long row0; int st;
            if (dir == 0) { st = 1; row0 = s0 < TCTX ? (long)NLAT + b * TCTX + s0 : (long)b * SEQ + (s0 - TCTX); }
            else { st = -1; row0 = s0 < TCTX ? (long)NLAT + b * TCTX + (TCTX - 1 - s0) : (long)b * SEQ + (SEQ - 1 - (s0 - TCTX)); }
            bf16_t la[16], uu[16];
#pragma unroll
            for (int k = 0; k < 16; ++k) { const size_t o = (size_t)(row0 + (long)st * k) * DRNN + ch; la[k] = LA[o]; uu[k] = U[o]; }
#pragma unroll
            for (int k = 0; k < 16; ++k) { const float l = bf1(la[k]); const float a = __builtin_amdgcn_exp2f(l * 1.4426950408889634f); hh = a * hh + __builtin_amdgcn_sqrtf(fmaxf(1.f - a * a, 0.f)) * bf1(uu[k]); sumla += l; }
        }
        sA[wid * 64 + lane] = sumla; sH[wid * 64 + lane] = hh;
        __syncthreads();
        float h = 0.f;
        for (int w2 = 0; w2 < wid; ++w2) h = __expf(sA[w2 * 64 + lane]) * h + sH[w2 * 64 + lane];
        for (int s0 = s_begin; s0 < s_begin + CH; s0 += 16) {
            long row0; int st;
            if (dir == 0) { st = 1; row0 = s0 < TCTX ? (long)NLAT + b * TCTX + s0 : (long)b * SEQ + (s0 - TCTX); }
            else { st = -1; row0 = s0 < TCTX ? (long)NLAT + b * TCTX + (TCTX - 1 - s0) : (long)b * SEQ + (SEQ - 1 - (s0 - TCTX)); }
            bf16_t la[16], uu[16], ex[16];
#pragma unroll
            for (int k = 0; k < 16; ++k) { const size_t o = (size_t)(row0 + (long)st * k) * DRNN + ch; la[k] = LA[o]; uu[k] = U[o]; }
            if (dir == 1) {
#pragma unroll
                for (int k = 0; k < 16; ++k) { const size_t o = (size_t)(row0 + (long)st * k) * DRNN + ch; ex[k] = R[o]; la[k] = la[k]; }
            }
            bf16_t gg[16];
            if (dir == 1) {
#pragma unroll
                for (int k = 0; k < 16; ++k) { const size_t o = (size_t)(row0 + (long)st * k) * DRNN + ch; gg[k] = Gb[o]; }
            }
#pragma unroll
            for (int k = 0; k < 16; ++k) { const size_t o = (size_t)(row0 + (long)st * k) * DRNN + ch; { const float a = __builtin_amdgcn_exp2f(bf1(la[k]) * 1.4426950408889634f); h = a * h + __builtin_amdgcn_sqrtf(fmaxf(1.f - a * a, 0.f)) * bf1(uu[k]); }
                if (dir == 0) R[o] = f2bf(h); else Gb[o] = f2bf(bf1(gg[k]) * (bf1(ex[k]) + h)); }
        }
        __syncthreads();
    }
}

__global__ __launch_bounds__(512, 2) void mk(Params p_unused, int ph0, int ph1) {
    extern __shared__ __attribute__((aligned(16))) unsigned char shm[];
    LAS unsigned char* lds3 = (LAS unsigned char*)shm; char* lds = (char*)shm;
    int wv = __builtin_amdgcn_readfirstlane((int)(threadIdx.x >> 6)); asm volatile("" : "+s"(wv));
    volatile LAS unsigned* bst = (volatile LAS unsigned*)(lds3 + 131072 + 2048);
    if (ph1 - ph0 > 1) {
        if (ltid(wv) == 0) { bst[0] = 0u; bst[1] = 0u; PP p0 = (PP)__builtin_amdgcn_kernarg_segment_ptr(); (void)xb_add(&((unsigned*)(p0->ws + O_BAR))[XB_XCNT(xb_xcc_id())], 1u); }
        __syncthreads();
    }
    for (int ph = ph0; ph < ph1; ++ph) {
        PP p = (PP)__builtin_amdgcn_kernarg_segment_ptr();
        asm volatile("" : "+s"(p));
        unsigned char* ws = p->ws;
        if (ph0 < 0) cg::this_grid().sync();
        else if (ph > ph0) xcd_barrier(wv, (unsigned*)(ws + O_BAR), bst);
#ifdef ONLY_OP
        const int op = ONLY_OP; const int layer = p->lay[ph];
#else
        const int op = p->op[ph], layer = p->lay[ph];
#endif
        const bool lastl = layer == 3;
        const bool ctx_dead = lastl || (layer == 2 && (op == OP_RES_LOUT || op == OP_NORM_MLP || op == OP_G_MLP1 || op == OP_RES_MLP2));
        const int M = ctx_dead ? NLAT : NTOK;
        const float* modl = (const float*)(ws + O_MOD) + (size_t)layer * 17 * 6144;
        bf16_t* xb = (bf16_t*)(ws + O_XB);
        const int fj = layer == 3 ? 1 : 0;
        switch (op) {
        case OP_PREP: prep_phase(wv, p, lds); break;
        case OP_NORM_MIX: {
            const bool fix = layer == 1 || layer == 2;
            if (layer == 0) norm_phase<true>(wv, p->x, p->ctx, xb, p->norm_mix_g, modl, 0, 1024, (bf16_t*)(ws + O_H), M);
            else norm_phase<false>(wv, nullptr, nullptr, xb, p->norm_mix_g + layer * 1024, modl, 0, 1024, (bf16_t*)(ws + O_H), M, fix ? (const float*)(ws + O_PART) : nullptr,
                                   (const float*)(ws + O_MOD) + ((size_t)(layer - 1) * 17 + 16) * 6144 + 5120);
            if (layer == 0 || layer == 3) dmat_gen(wv, (bf16_t*)(ws + O_CST), lds);
        } break;
        case OP_NORM_MLP: norm_phase<false>(wv, nullptr, nullptr, xb, p->norm_mlp_g + layer * 1024, modl, 3072, 4096, (bf16_t*)(ws + O_H), M); break;
        case OP_G_PQ: { EpiPQT E; E.PP = (bf16_t*)(ws + O_PQTP); E.PQ = (bf16_t*)(ws + O_PQTQ); E.P64 = (bf16_t*)(ws + O_PQT64); E.PC = (bf16_t*)(ws + O_PQTC);
            run_gemm(wv, lds3, (const bf16_t*)(ws + O_WPQT) + (size_t)fj * 1024 * 1024, 1024, (const bf16_t*)(ws + O_H), 1024, M, 1024, E); } break;
        case OP_FOLD: fold_phase(wv, (const bf16_t*)(ws + O_PQTP), (bf16_t*)(ws + O_FOLD)); break;
        case OP_G_DFT: case OP_G_DFTC: {
#pragma nounroll
            for (int gi = 0; gi < 3; ++gi) { const int g = gi == 0 ? 2 : gi - 1;
                if (g == 0 && lastl) continue;
                EpiDFTS E; E.F = (bf16_t*)(ws + O_F); E.mode = g == 2 ? 0 : (g == 1 ? 1 : 2); E.scale = g == 0 ? 0.005524271728019903f : 0.0013810679320049757f;
                const bf16_t* A = (const bf16_t*)(ws + (g == 0 ? O_D256 : O_CST)); const bf16_t* Bt = g == 0 ? (const bf16_t*)(ws + O_PQTC) : (const bf16_t*)(ws + O_FOLD) + (g == 1 ? (size_t)16384 * KF : 0);
                const int Mg = g == 0 ? 512 : 2048, Ng = g == 1 ? 256 : 16384, Kg = g == 0 ? 256 : KF;
                pg8::DftOrder S; S.init(Mg, Ng, (int)gridDim.x, g == 1 ? (int)((blockIdx.x + gridDim.x - 128) % gridDim.x) : (int)blockIdx.x); S.kq = g == 2 ? 2048 * KF * 2 : 0; S.kcls = g == 0 ? 0 : (int)FOLD_CLS;
                pg8::Gemm gm; gm.A = A; gm.Bt = Bt; gm.M = Mg; gm.N = Ng; gm.K = Kg; gm.lda = Kg; gm.ldb = Kg;
                pg8::gemm_phase<EpiDFTS, pg8::DftOrder>(wv, lds3, gm, S, E);
            }
            nyquist_pass(wv, (const bf16_t*)(ws + O_PQTP), (const bf16_t*)(ws + O_PQT64), (bf16_t*)(ws + O_F), 0.0013810679320049757f);
        } break;
        case OP_RES_FOUT: case OP_RES_MLP2: case OP_RES_WO: case OP_RES_LOUT: {
            const bool split = (op == OP_RES_MLP2 && layer < 2);
            const bf16_t* A; const bf16_t* Bt; int K;
            if (op == OP_RES_FOUT) { A = (const bf16_t*)(ws + O_F); Bt = (const bf16_t*)(ws + O_FWOT) + (size_t)fj * 1024 * 1024; K = 1024; }
            else if (op == OP_RES_MLP2) { A = (const bf16_t*)(ws + O_BIG); Bt = (const bf16_t*)(ws + O_W2T) + (size_t)layer * DFF * 1024; K = DFF; }
            else if (op == OP_RES_WO) { A = (const bf16_t*)(ws + O_H); Bt = (const bf16_t*)(ws + O_WOT); K = 1024; }
            else { A = (const bf16_t*)(ws + O_G); Bt = (const bf16_t*)(ws + O_LWOT); K = DRNN; }
#pragma nounroll
            for (int g = 0; g < (split ? 2 : 1); ++g) {
                EpiRes E; E.xb = xb; E.gate = modl + (op == OP_RES_MLP2 ? 5120 : 2048);
                E.part = g ? (float*)(ws + O_PART) : nullptr;
                pg8::ResOrder S; S.split = g;
                if (g == 0) S.init(split ? NLAT : M, 1024, (int)gridDim.x, (int)blockIdx.x); else S.init(NCTX, 4096, (int)gridDim.x, (int)blockIdx.x);
                pg8::Gemm gm; gm.A = g ? A + (size_t)NLAT * DFF : A; gm.Bt = Bt; gm.M = 0; gm.N = 0; gm.K = g ? 1024 : K; gm.lda = K; gm.ldb = K;
                pg8::gemm_phase<EpiRes, pg8::ResOrder>(wv, lds3, gm, S, E);
            } } break;
        case OP_G_MLP1: { EpiRelu2 E; E.O = (bf16_t*)(ws + O_BIG); E.ldc = DFF;
            run_gemm(wv, lds3, (const bf16_t*)(ws + O_H), 1024, (const bf16_t*)(ws + O_W1T) + (size_t)layer * DFF * 1024, M, DFF, 1024, E); } break;
        case OP_G_QKV: { EpiQKV E; E.Q = (bf16_t*)(ws + O_Q); E.KB = (bf16_t*)(ws + O_KB); E.VB = (bf16_t*)(ws + O_VB); E.qg = p->q_g; E.kg = p->k_g; E.rope = (const float*)(ws + O_ROPE); E.red = (LAS float*)(lds3 + 131072 + 4096);
            run_gemm(wv, lds3, (const bf16_t*)(ws + O_H), 1024, (const bf16_t*)(ws + O_WQKVT), M, 1536, 1024, E); } break;
        case OP_QKNORM: qknorm_phase(wv, (const bf16_t*)(ws + O_QKVRAW), (bf16_t*)(ws + O_Q), (bf16_t*)(ws + O_KB), (bf16_t*)(ws + O_VB), p->q_g, p->k_g, lds); break;
        case OP_ATTN: attn_phase(wv, (const bf16_t*)(ws + O_Q), (const bf16_t*)(ws + O_KB), (const bf16_t*)(ws + O_VB), (bf16_t*)(ws + O_H), lds); break;
        case OP_G_LRUIN: { EpiLruIn E; E.G = (bf16_t*)(ws + O_G); E.XR = (bf16_t*)(ws + O_XR);
            run_gemm(wv, lds3, (const bf16_t*)(ws + O_H), 1024, (const bf16_t*)(ws + O_LWINT), M, 2560, 1024, E); } break;
        case OP_CONV: conv_phase(wv, (const bf16_t*)(ws + O_XR), (bf16_t*)(ws + O_XCONV), p->conv_w, p->conv_b); break;
        case OP_G_GATE0: case OP_G_GATE1: { const int d = op == OP_G_GATE1 ? 1 : 0;
            EpiGate E; E.XC = (const bf16_t*)(ws + O_XCONV); E.LA = (bf16_t*)(ws + O_LA); E.U = (bf16_t*)p->out; E.gpar = (const float*)(ws + O_GPAR) + (size_t)d * 3 * DRNN;
            run_gemm<EpiGate, pg8::GateOrder>(wv, lds3, (const bf16_t*)(ws + O_XCONV), DRNN, (const bf16_t*)(ws + O_GATET) + (size_t)d * 2560 * 256, M, 2560, 256, E); } break;
        case OP_SCAN0: scan_phase(wv, 0, (const bf16_t*)(ws + O_LA), (const bf16_t*)p->out, (bf16_t*)(ws + O_XR), (bf16_t*)(ws + O_G), lds); break;
        case OP_SCAN1: scan_phase(wv, 1, (const bf16_t*)(ws + O_LA), (const bf16_t*)p->out, (bf16_t*)(ws + O_XR), (bf16_t*)(ws + O_G), lds); break;
        case OP_FINAL: final_phase(wv, xb, p->out, p->final_g); break;
        default: break;
        }
    }
}

extern "C" void kernel_launch(void* const* d_in, const int* in_sizes, int n_in, void* d_out, int out_size, void* d_ws, size_t ws_size, hipStream_t stream) {
    Params p; memset(&p, 0, sizeof(p));
    const float** f = (const float**)&p;
    for (int i = 0; i < 26 && i < n_in; ++i) f[i] = (const float*)d_in[i];
    p.out = (float*)d_out; p.ws = (unsigned char*)d_ws;
    int n = 0;
#ifndef PROBE_DUP
#define PROBE_DUP -1
#endif
    auto add = [&](int op, int layer) { const int reps = (op == PROBE_DUP) ? 2 : 1; for (int r = 0; r < reps; ++r) { p.op[n] = (unsigned char)op; p.lay[n] = (unsigned char)layer; ++n; } };
    add(OP_PREP, 0);
    add(OP_NORM_MIX, 0); add(OP_G_PQ, 0); add(OP_FOLD, 0); add(OP_G_DFT, 0); add(OP_RES_FOUT, 0); add(OP_NORM_MLP, 0); add(OP_G_MLP1, 0); add(OP_RES_MLP2, 0);
    add(OP_NORM_MIX, 1); add(OP_G_QKV, 1); add(OP_ATTN, 1); add(OP_RES_WO, 1); add(OP_NORM_MLP, 1); add(OP_G_MLP1, 1); add(OP_RES_MLP2, 1);
    add(OP_NORM_MIX, 2); add(OP_G_LRUIN, 2); add(OP_CONV, 2); add(OP_G_GATE0, 2); add(OP_SCAN0, 2); add(OP_G_GATE1, 2); add(OP_SCAN1, 2); add(OP_RES_LOUT, 2);
    add(OP_NORM_MLP, 2); add(OP_G_MLP1, 2); add(OP_RES_MLP2, 2);
    add(OP_NORM_MIX, 3); add(OP_G_PQ, 3); add(OP_FOLD, 3); add(OP_G_DFT, 3); add(OP_RES_FOUT, 3); add(OP_NORM_MLP, 3); add(OP_G_MLP1, 3); add(OP_RES_MLP2, 3);
    add(OP_FINAL, 3);
    static int grid = 0;
    if (!grid) {
        hipFuncSetAttribute((const void*)mk, hipFuncAttributeMaxDynamicSharedMemorySize, LDS_BYTES);
        int dev = 0, cus = 0, per_cu = 0; hipGetDevice(&dev); hipDeviceGetAttribute(&cus, hipDeviceAttributeMultiprocessorCount, dev);
        hipOccupancyMaxActiveBlocksPerMultiprocessor(&per_cu, mk, 512, LDS_BYTES);
        if (per_cu < 1) { fprintf(stderr, "occupancy query returned %d\n", per_cu); per_cu = 1; }
        grid = cus > 0 ? cus : 256;
    }
#if MK_LAUNCHES == 1
    hipMemsetAsync((char*)d_ws + O_BAR, 0, BAR_BYTES, stream);
    int ph0 = 0, ph1 = n; void* args[] = {&p, &ph0, &ph1};
    hipError_t e = hipLaunchCooperativeKernel((void*)mk, dim3(grid), dim3(512), args, LDS_BYTES, stream);
    if (e != hipSuccess) fprintf(stderr, "cooperative launch failed: %s\n", hipGetErrorString(e));
#else
    for (int ph = 0; ph < n; ++ph) hipLaunchKernelGGL(mk, dim3(grid), dim3(512), LDS_BYTES, stream, p, ph, ph + 1);
#endif
}
```

```cpp
#include <hip/hip_runtime.h>
#include <hip/hip_cooperative_groups.h>
#include <cstdio>
#include <cstring>
#include <cstdint>
namespace cg = cooperative_groups;

#ifndef MK_LAUNCHES
#define MK_LAUNCHES 1
#endif

#define LAS __attribute__((address_space(3)))
typedef unsigned short bf16_t;
typedef short bf16x8 __attribute__((ext_vector_type(8)));
typedef short s16x4 __attribute__((ext_vector_type(4)));
typedef float f32x4 __attribute__((ext_vector_type(4)));
typedef float f32x16 __attribute__((ext_vector_type(16)));
typedef unsigned u32x4 __attribute__((ext_vector_type(4)));
typedef unsigned u32x2 __attribute__((ext_vector_type(2)));

constexpr int DM = 1024, NBATCH = 16, SEQ = 4096, TCTX = 256, NLAT = NBATCH * SEQ, NCTX = NBATCH * TCTX, NTOK = NLAT + NCTX;
constexpr int DFF = 4096, DRNN = 1280, SKV = SEQ + TCTX;
constexpr int LDS_BYTES = 131072 + 4096 + 8192;

constexpr size_t al256(size_t x) { return (x + 255) & ~(size_t)255; }
constexpr size_t O_MOD = 0;
constexpr size_t O_XB = al256(O_MOD + 4ull * 17 * 6144 * 4);
constexpr size_t O_W1T = O_XB + (size_t)NTOK * DM * 2;
constexpr size_t O_W2T = O_W1T + 4ull * DFF * DM * 2;
constexpr size_t O_WPQT = O_W2T + 4ull * DFF * DM * 2;
constexpr size_t O_FWOT = O_WPQT + 2ull * 2048 * 1024 * 2;
constexpr size_t O_WQKVT = O_FWOT + 2ull * 1024 * 1024 * 2;
constexpr size_t O_WOT = O_WQKVT + 1536ull * 1024 * 2;
constexpr size_t O_LWINT = O_WOT + 1024ull * 1024 * 2;
constexpr size_t O_GATET = O_LWINT + 2560ull * 1024 * 2;
constexpr size_t O_LWOT = O_GATET + 2ull * 2560 * 256 * 2;
constexpr size_t O_D256 = O_LWOT + 1024ull * 1280 * 2;
constexpr size_t O_ROPE = al256(O_D256 + 256ull * 512 * 2);
constexpr int KF = 1152;
constexpr size_t O_CST = al256(O_ROPE + 64ull * 32 * 2 * 4);
constexpr size_t O_GPAR = al256(O_CST + 4ull * 1024 * KF * 2);
constexpr size_t O_BAR = al256(O_GPAR + 2ull * 3 * 1280 * 4);
constexpr size_t BAR_BYTES = 16384;
constexpr size_t O_TMP = al256(O_BAR + BAR_BYTES);
constexpr size_t O_H = O_TMP;
constexpr size_t O_BIG = O_H + (size_t)NTOK * DM * 2;
constexpr size_t BIG_END = O_BIG + (size_t)NTOK * DFF * 2;
constexpr size_t O_PQTP = O_BIG;
constexpr size_t O_PQTQ = O_PQTP + 8192ull * 4096 * 2;
constexpr size_t O_PQT64 = O_PQTQ + 8192ull * 4096 * 2;
constexpr size_t O_PQTC = O_PQT64 + 256ull * 4096 * 2;
constexpr size_t FOLD_CLS = 16640ull * KF * 2;
constexpr size_t O_FOLD = O_PQTC + 16ull * 1024 * 256 * 2;
constexpr size_t O_F = al256(O_FOLD + 2 * FOLD_CLS);
static_assert(O_F + (size_t)NTOK * DM * 2 <= BIG_END, "fourier temporaries");
constexpr size_t O_QKVRAW = O_BIG;
constexpr size_t O_Q = O_QKVRAW + (size_t)NTOK * 1536 * 2;
constexpr size_t O_KB = O_Q + (size_t)NTOK * 1024 * 2;
constexpr size_t O_VB = O_KB + 16ull * SKV * 256 * 2;
static_assert(O_VB + 16ull * SKV * 256 * 2 <= BIG_END, "attention temporaries");
constexpr size_t LRU_SLOT = (size_t)NTOK * DRNN * 2;
constexpr size_t O_XCONV = O_TMP, O_G = O_TMP + LRU_SLOT, O_XR = O_TMP + 2 * LRU_SLOT, O_LA = O_TMP + 3 * LRU_SLOT;
static_assert(O_TMP + 4 * LRU_SLOT <= (1ull << 30), "lru temporaries");
static_assert(LRU_SLOT <= (size_t)NLAT * DM * 4, "U slot fits d_out");
constexpr size_t O_PART = BIG_END;
static_assert(O_PART + 4ull * NCTX * DM * 4 <= (1ull << 30), "ws");
static_assert(O_G >= O_H + (size_t)NTOK * DM * 2, "G must not overlap H");

enum { OP_PREP = 0, OP_NORM_MIX, OP_NORM_MLP, OP_G_PQ, OP_G_DFT, OP_RES_FOUT, OP_G_MLP1, OP_RES_MLP2, OP_G_QKV, OP_QKNORM, OP_ATTN, OP_RES_WO,
       OP_G_LRUIN, OP_CONV, OP_G_GATE0, OP_SCAN0, OP_G_GATE1, OP_SCAN1, OP_RES_LOUT, OP_FINAL, OP_G_DFTC, OP_FOLD };

struct Params {
    const float *x, *c, *ctx, *c_ctx, *ada_w, *ada_b, *norm_mix_g, *norm_mlp_g, *mlp_w1, *mlp_w2, *fnet_w_in, *fnet_w_out, *attn_w_qkv, *attn_w_o, *q_g, *k_g,
        *lru_w_in, *conv_w, *conv_b, *ga_w, *ga_b, *gx_w, *gx_b, *lam, *lru_w_out, *final_g;
    float* out; unsigned char* ws;
    unsigned char op[48]; unsigned char lay[48];
};

__device__ __forceinline__ unsigned cvtpk(float lo, float hi) { unsigned r; asm volatile("v_cvt_pk_bf16_f32 %0, %1, %2" : "=v"(r) : "v"(lo), "v"(hi)); return r; }
__device__ __forceinline__ float bflo(unsigned w) { return __uint_as_float(w << 16); }
__device__ __forceinline__ float bfhi(unsigned w) { return __uint_as_float(w & 0xffff0000u); }
__device__ __forceinline__ float bf1(bf16_t h) { return __uint_as_float(((unsigned)h) << 16); }
__device__ __forceinline__ bf16_t f2bf(float f) { return (bf16_t)(cvtpk(f, 0.f) & 0xffffu); }
__device__ __forceinline__ float lane_xor(float v, int lane, int o) { return __int_as_float(__builtin_amdgcn_ds_bpermute((lane ^ o) << 2, __float_as_int(v))); }
__device__ __forceinline__ float wave_sum(float v, int lane) {
#pragma unroll
    for (int o = 32; o >= 1; o >>= 1) v += lane_xor(v, lane, o);
    return v;
}
__device__ __forceinline__ int ltid(const int wv) {
    int lane; asm volatile("v_mbcnt_lo_u32_b32 %0, -1, 0\n\tv_mbcnt_hi_u32_b32 %0, -1, %0" : "=v"(lane));
    int t = (wv << 6) | lane; asm volatile("" : "+v"(t)); return t; }
__device__ __forceinline__ float sigmoidf_(float z) { return 1.f / (1.f + __expf(-z)); }

#define XB_TMO      128
#define XB_XCNT(j)  (256  + 64 * (j))
#define XB_XSUB(j)  (1280 + 64 * (j))
#define XB_XGEN(j)  (2304 + 64 * (j))
#define XB_TOP      3328
#define XB_TOPGEN   3392
#define XCD_BAR_WORDS 3456
#define XB_SPIN_CAP (1u << 18)
__device__ __forceinline__ unsigned xb_ld(unsigned* p)              { return __hip_atomic_load(p, __ATOMIC_RELAXED, __HIP_MEMORY_SCOPE_AGENT); }
__device__ __forceinline__ unsigned xb_add(unsigned* p, unsigned v) { return __hip_atomic_fetch_add(p, v, __ATOMIC_RELAXED, __HIP_MEMORY_SCOPE_AGENT); }
__device__ __forceinline__ unsigned xb_xcc_id() { return (unsigned)__builtin_amdgcn_s_getreg((3 << 11) | 20) & 0xFu; }
#define XB_SPIN(cond, bar) do { unsigned _sp = 0; while (cond) { __builtin_amdgcn_s_sleep(1); \
    if ((++_sp & 255u) == 0u) { if (xb_ld(&(bar)[XB_TMO])) break; if (_sp > XB_SPIN_CAP) { atomicAdd(&(bar)[XB_TMO], 1u); break; } } } } while (0)
__device__ __forceinline__ void xcd_barrier_complete(unsigned* bar, unsigned x, unsigned& nloc, unsigned& nx) {
    const unsigned G = gridDim.x * gridDim.y * gridDim.z;
    unsigned sum, cnt, mine, sp = 0u;
    for (;;) {
        sum = 0u; cnt = 0u; mine = 0u;
#pragma unroll
        for (unsigned j = 0; j < 16; ++j) { const unsigned c = xb_ld(&bar[XB_XCNT(j)]); sum += c; cnt += (c > 0u) ? 1u : 0u; mine = (j == x) ? c : mine; }
        if (sum == G) break;
        __builtin_amdgcn_s_sleep(1);
        if ((++sp & 255u) == 0u) { if (xb_ld(&bar[XB_TMO])) break; if (sp > XB_SPIN_CAP) { atomicAdd(&bar[XB_TMO], 1u); break; } }
    }
    nloc = mine > 0u ? mine : 1u; nx = cnt > 0u ? cnt : 1u;
}
__device__ __forceinline__ void xcd_barrier(const int wv, unsigned* bar, volatile LAS unsigned* st) {
    asm volatile("s_waitcnt vmcnt(0)" ::: "memory");
    __syncthreads();
    if (ltid(wv) == 0) {
        const unsigned x = xb_xcc_id();
        __builtin_amdgcn_s_waitcnt(0);
        unsigned nloc = st[0], nx = st[1];
        if (nloc == 0u) { xcd_barrier_complete(bar, x, nloc, nx); st[0] = nloc; st[1] = nx; }
        const unsigned old = xb_add(&bar[XB_XSUB(x)], 1u);
        const unsigned gen = old / nloc;
        if (old + 1u == (gen + 1u) * nloc) {
            __builtin_amdgcn_fence(__ATOMIC_RELEASE, "agent");
            asm volatile("s_waitcnt vmcnt(0)" ::: "memory");
            const unsigned og = xb_add(&bar[XB_TOP], 1u);
            const unsigned tg = og / nx;
            if (og + 1u == (tg + 1u) * nx) xb_add(&bar[XB_TOPGEN], 1u);
            else XB_SPIN(xb_ld(&bar[XB_TOPGEN]) == tg, bar);
            __builtin_amdgcn_fence(__ATOMIC_ACQUIRE, "agent");
            xb_add(&bar[XB_XGEN(x)], 1u);
            asm volatile("s_waitcnt vmcnt(0)" ::: "memory");
        } else {
            XB_SPIN(xb_ld(&bar[XB_XGEN(x)]) == gen, bar);
            __builtin_amdgcn_fence(__ATOMIC_ACQUIRE, "agent");
            asm volatile("s_waitcnt vmcnt(0)" ::: "memory");
        }
    }
    __syncthreads();
}

namespace pg8 {
constexpr int BM = 256, BK = 64, HALF = 128, HTB = HALF * BK * 2, STAGE_BYTES = 8 * HTB, NXCD = 8, WGM = 8;
__device__ __forceinline__ int lds_byte(int r, int c) { const int st = (r >> 4) * 2 + (c >> 5), rr = r & 15, cc = c & 31, ob = rr * 64 + cc * 2; return st * 1024 + (ob ^ (((ob >> 9) & 1) << 5)); }
__device__ __forceinline__ void stage_rc(int b, int& R, int& C) { const int st = b / 1024, sb = b % 1024, swz = sb ^ (((sb >> 9) & 1) << 5); R = (st >> 1) * 16 + swz / 64; C = (st & 1) * 32 + (swz % 64) / 2; }
__device__ __forceinline__ int perm32(int rho) { const int n = rho >> 4, i = rho & 15; return 8 * (i >> 2) + 4 * n + (i & 3); }
struct Unit { int pm, pn, koff, koffB, ks; };
struct Gemm { const bf16_t* A; const bf16_t* Bt; int M, N, K, lda, ldb; };
struct StaticOrder {
    int nM, nN, nwg, G, c;
    __device__ void init(int M, int N, int G_, int c_) { nM = M / BM; nN = N / BM; nwg = nM * nN; G = G_; c = c_; }
    __device__ bool next(int i, Unit& u) const {
        const long L = (long)i * G + c; if (L >= nwg) return false;
        int wgid = (int)L; { const int q = nwg / NXCD, r = nwg % NXCD, xcd = wgid % NXCD, off = wgid / NXCD; wgid = (xcd < r ? xcd * (q + 1) : r * (q + 1) + (xcd - r) * q) + off; }
        const int nig = WGM * nN, gid = wgid / nig, fm = gid * WGM, gsz = (nM - fm) < WGM ? (nM - fm) : WGM;
        u.pm = fm + ((wgid % nig) % gsz); u.pn = (wgid % nig) / gsz; u.koff = 0; u.koffB = 0; u.ks = 0; return true;
    }
};
struct DftOrder : StaticOrder {
    int kq, kcls;
    __device__ bool next(int i, Unit& u) const { if (!StaticOrder::next(i, u)) return false; u.koff = (u.pn >= 32) ? kq : 0; u.koffB = (u.pm >> 2) * kcls; return true; }
};
struct ResOrder : StaticOrder {
    int split;
    __device__ bool next(int i, Unit& u) const { if (!StaticOrder::next(i, u)) return false; if (split) { const int ks = u.pn >> 2; u.pn &= 3; u.koff = ks * 2048; u.koffB = ks * 2048; u.ks = ks; } return true; }
};
struct GateOrder : StaticOrder {
    __device__ bool next(int i, Unit& u) const { if (!StaticOrder::next(i, u)) return false; u.koff = (u.pn >> 1) * 512; return true; }
};

template <class Epi, class Sched>
__device__ __forceinline__ void gemm_phase(const int wv, LAS unsigned char* lds, const Gemm g, const Sched& S, const Epi& E) {
    const int tid = ltid(wv), wid = __builtin_amdgcn_readfirstlane(tid >> 6), lane = tid & 63, wr = wid >> 2, wc = wid & 3, fr = lane & 15, fq = lane >> 4;
    const int K = g.K, nt = K / BK, lda = g.lda, ldb = g.ldb;
    unsigned voffA[2], voffB[2];
#pragma unroll
    for (int i = 0; i < 2; ++i) { int R, C; stage_rc(tid * 16 + i * 8192, R, C); const int Rb = Epi::PERM ? ((R & ~31) + perm32(R & 31)) : R; voffA[i] = (unsigned)(R * lda + C) * 2u; voffB[i] = (unsigned)(Rb * ldb + C) * 2u; }
    const size_t kstep = (size_t)(BK * 2);
    const size_t hstepA = (size_t)HALF * lda * 2, hstepB = (size_t)HALF * ldb * 2;
    const size_t tstepA = 2 * hstepA, tstepB = 2 * hstepB;
    const unsigned ldsw = (unsigned)wid * 1024u;
    const int aoff = lds_byte(wr * 64 + fr, fq * 8), boff = lds_byte(wc * 32 + fr, fq * 8);
#define PG8_SA(b, h) (((b) * 2 + (h)) * HTB)
#define PG8_SB(b, h) ((4 + (b) * 2 + (h)) * HTB)
#define PG8_STAGE(bufoff, gbase, voff) do { _Pragma("unroll") for (int _i = 0; _i < 2; ++_i) \
        __builtin_amdgcn_global_load_lds((const unsigned*)((const char*)(gbase) + (voff)[_i]), (LAS unsigned*)(lds + (bufoff) + ldsw + _i * 8192), 16, 0, 0); } while (0)
#define PG8_LDA(dst, b, h) do { _Pragma("unroll") for (int m = 0; m < 4; ++m) _Pragma("unroll") for (int k = 0; k < 2; ++k) dst[m][k] = *(const LAS bf16x8*)(lds + PG8_SA(b, h) + aoff + m * 2048 + k * 1024); } while (0)
#define PG8_LDB(dst, b, h) do { _Pragma("unroll") for (int n = 0; n < 2; ++n) _Pragma("unroll") for (int k = 0; k < 2; ++k) dst[n][k] = *(const LAS bf16x8*)(lds + PG8_SB(b, h) + boff + n * 2048 + k * 1024); } while (0)
#define PG8_MMA(ai, bj, At, Bt) do { __builtin_amdgcn_s_setprio(1); _Pragma("unroll") for (int m = 0; m < 4; ++m) _Pragma("unroll") for (int n = 0; n < 2; ++n) _Pragma("unroll") for (int k = 0; k < 2; ++k) \
        acc[ai][bj][m][n] = __builtin_amdgcn_mfma_f32_16x16x32_bf16(Bt[n][k], At[m][k], acc[ai][bj][m][n], 0, 0, 0); __builtin_amdgcn_s_setprio(0); } while (0)
#define PG8_WAIT_V(n) asm volatile("s_waitcnt vmcnt(" #n ")" ::: "memory")
#define PG8_WAIT_L(n) asm volatile("s_waitcnt lgkmcnt(" #n ")" ::: "memory")
#define PG8_BAR __builtin_amdgcn_s_barrier()
#define PG8_SCHED __builtin_amdgcn_sched_barrier(0)
    Unit cur, nxt; int ui = 0;
    if (!S.next(0, cur)) return;
    f32x4 acc[2][2][4][2];
#pragma unroll
    for (int a = 0; a < 2; ++a)
#pragma unroll
        for (int b = 0; b < 2; ++b)
#pragma unroll
            for (int m = 0; m < 4; ++m)
#pragma unroll
                for (int n = 0; n < 2; ++n) acc[a][b][m][n] = (f32x4){0.f, 0.f, 0.f, 0.f};
    bf16x8 At[4][2], B0[2][2], B1[2][2];
    const char* cA = (const char*)g.A + (size_t)cur.pm * tstepA + cur.koff; const char* cB = (const char*)g.Bt + (size_t)cur.pn * tstepB + cur.koffB;
    PG8_STAGE(PG8_SB(0, 0), cB, voffB); PG8_STAGE(PG8_SA(0, 0), cA, voffA); PG8_STAGE(PG8_SB(0, 1), cB + hstepB, voffB); PG8_STAGE(PG8_SA(0, 1), cA + hstepA, voffA);
    if (wr == 1) PG8_BAR;
    PG8_WAIT_V(4); PG8_BAR;
    PG8_STAGE(PG8_SB(1, 0), cB + kstep, voffB); PG8_STAGE(PG8_SA(1, 0), cA + kstep, voffA); PG8_STAGE(PG8_SB(1, 1), cB + hstepB + kstep, voffB);
    PG8_WAIT_V(6); PG8_BAR;
    for (;;) {
        const bool has_next = S.next(ui + 1, nxt);
        const char* nA = has_next ? (const char*)g.A + (size_t)nxt.pm * tstepA + nxt.koff : cA; const char* nB = has_next ? (const char*)g.Bt + (size_t)nxt.pn * tstepB + nxt.koffB : cB;
        for (int t = 0; t < nt; t += 2) {
            const bool last = (t == nt - 2);
            const char* a1 = cA + (size_t)(t + 1) * kstep;
            const char* a2 = last ? nA : cA + (size_t)(t + 2) * kstep; const char* b2 = last ? nB : cB + (size_t)(t + 2) * kstep;
            const char* a3 = a2 + kstep; const char* b3 = b2 + kstep;
            PG8_LDB(B0, 0, 0); PG8_SCHED; PG8_LDA(At, 0, 0); PG8_STAGE(PG8_SA(1, 1), a1 + hstepA, voffA);
            PG8_WAIT_L(8); PG8_BAR; PG8_WAIT_L(0); PG8_MMA(0, 0, At, B0); PG8_BAR; PG8_SCHED;
            PG8_LDB(B1, 0, 1); PG8_STAGE(PG8_SB(0, 0), b2, voffB);
            PG8_BAR; PG8_WAIT_L(0); PG8_MMA(0, 1, At, B1); PG8_BAR;
            PG8_LDA(At, 0, 1); PG8_STAGE(PG8_SA(0, 0), a2, voffA);
            PG8_BAR; PG8_WAIT_L(0); PG8_MMA(1, 0, At, B0); PG8_BAR; PG8_SCHED;
            PG8_STAGE(PG8_SB(0, 1), b2 + hstepB, voffB);
            PG8_WAIT_V(6); PG8_BAR; PG8_MMA(1, 1, At, B1); PG8_BAR;
            PG8_LDB(B0, 1, 0); PG8_SCHED; PG8_LDA(At, 1, 0); PG8_STAGE(PG8_SA(0, 1), a2 + hstepA, voffA);
            PG8_WAIT_L(8); PG8_BAR; PG8_WAIT_L(0); PG8_MMA(0, 0, At, B0); PG8_BAR; PG8_SCHED;
            PG8_LDB(B1, 1, 1); PG8_STAGE(PG8_SB(1, 0), b3, voffB);
            PG8_BAR; PG8_WAIT_L(0); PG8_MMA(0, 1, At, B1); PG8_BAR;
            PG8_LDA(At, 1, 1); PG8_STAGE(PG8_SA(1, 0), a3, voffA);
            PG8_BAR; PG8_WAIT_L(0); PG8_MMA(1, 0, At, B0); PG8_BAR; PG8_SCHED;
            PG8_STAGE(PG8_SB(1, 1), b3 + hstepB, voffB);
            PG8_WAIT_V(6); PG8_BAR; PG8_MMA(1, 1, At, B1); PG8_BAR;
        }
        E(acc, cur, wr, wc, fr, fq);
        if (!has_next) break;
#pragma unroll
        for (int a = 0; a < 2; ++a)
#pragma unroll
            for (int b = 0; b < 2; ++b)
#pragma unroll
                for (int m = 0; m < 4; ++m)
#pragma unroll
                    for (int n = 0; n < 2; ++n) acc[a][b][m][n] = (f32x4){0.f, 0.f, 0.f, 0.f};
        cur = nxt; cA = nA; cB = nB; ++ui;
    }
    PG8_WAIT_V(0);
    if (wr == 0) PG8_BAR;
    PG8_BAR;
#undef PG8_SA
#undef PG8_SB
#undef PG8_STAGE
#undef PG8_LDA
#undef PG8_LDB
#undef PG8_MMA
#undef PG8_WAIT_V
#undef PG8_WAIT_L
#undef PG8_BAR
#undef PG8_SCHED
}
}
using pg8::Unit;
typedef f32x4 Acc[2][2][4][2];

__device__ __forceinline__ void st_bf4(bf16_t* p, f32x4 v) { u32x2 w = {cvtpk(v[0], v[1]), cvtpk(v[2], v[3])}; *(u32x2*)p = w; }
__device__ __forceinline__ void st_bf8(bf16_t* p, f32x4 a, f32x4 b) { u32x4 w = {cvtpk(a[0], a[1]), cvtpk(a[2], a[3]), cvtpk(b[0], b[1]), cvtpk(b[2], b[3])}; *(u32x4*)p = w; }
__device__ __forceinline__ void st_bf8_o(bf16_t* base, unsigned eoff, f32x4 a, f32x4 b) { u32x4 w = {cvtpk(a[0], a[1]), cvtpk(a[2], a[3]), cvtpk(b[0], b[1]), cvtpk(b[2], b[3])}; *(u32x4*)((char*)base + (size_t)(eoff * 2u)) = w; }
__device__ __forceinline__ u32x4 ld_bf8_o(const bf16_t* base, unsigned eoff) { return *(const u32x4*)((const char*)base + (size_t)(eoff * 2u)); }
__device__ __forceinline__ void st_bf4_o(bf16_t* base, unsigned eoff, f32x4 v) { u32x2 w = {cvtpk(v[0], v[1]), cvtpk(v[2], v[3])}; *(u32x2*)((char*)base + (size_t)(eoff * 2u)) = w; }

struct EpiBf16 {
    static constexpr bool PERM = false;
    bf16_t* O; int ldc;
    __device__ __forceinline__ void operator()(const Acc& acc, const Unit& u, int wr, int wc, int fr, int fq) const {
        const int row0 = u.pm * 256 + wr * 64 + fr, col0 = u.pn * 256 + wc * 32 + 4 * fq;
#pragma unroll
        for (int ai = 0; ai < 2; ++ai)
#pragma unroll
            for (int m = 0; m < 4; ++m) { bf16_t* rp = O + (size_t)(row0 + ai * 128 + m * 16) * ldc + col0;
#pragma unroll
                for (int bj = 0; bj < 2; ++bj)
#pragma unroll
                    for (int n = 0; n < 2; ++n) st_bf4(rp + bj * 128 + n * 16, acc[ai][bj][m][n]); }
    }
};
struct EpiRelu2 {
    static constexpr bool PERM = true;
    bf16_t* O; int ldc;
    __device__ __forceinline__ void operator()(const Acc& acc, const Unit& u, int wr, int wc, int fr, int fq) const {
        const int row0 = u.pm * 256 + wr * 64 + fr, col0 = u.pn * 256 + wc * 32 + 8 * fq;
#pragma unroll
        for (int ai = 0; ai < 2; ++ai)
#pragma unroll
            for (int m = 0; m < 4; ++m) { bf16_t* rp = O + (size_t)(row0 + ai * 128 + m * 16) * ldc + col0;
#pragma unroll
                for (int bj = 0; bj < 2; ++bj) { f32x4 v0 = acc[ai][bj][m][0], v1 = acc[ai][bj][m][1];
#pragma unroll
                    for (int j = 0; j < 4; ++j) { const float t0 = fmaxf(v0[j], 0.f), t1 = fmaxf(v1[j], 0.f); v0[j] = t0 * t0; v1[j] = t1 * t1; }
                    const u32x4 w = {cvtpk(v0[0], v0[1]), cvtpk(v0[2], v0[3]), cvtpk(v1[0], v1[1]), cvtpk(v1[2], v1[3])};
                    *(u32x4*)(rp + bj * 128) = w; } }
    }
};
struct EpiPQT {
    static constexpr bool PERM = true;
    bf16_t* PP; bf16_t* PQ; bf16_t* P64; bf16_t* PC;
    __device__ __forceinline__ void operator()(const Acc& acc, const Unit& u, int wr, int wc, int fr_, int fq_) const {
        int fr = fr_, fq = fq_; asm volatile("" : "+v"(fr), "+v"(fq));
        const int row0 = u.pm * 256 + wr * 64 + fr, tok0 = u.pn * 256; const bool lat = tok0 < NLAT;
        const int b = lat ? (tok0 >> 12) : ((tok0 - NLAT) >> 8); const int c0 = (lat ? (tok0 & 4095) : 0) + wc * 32 + 8 * fq;
#pragma unroll
        for (int ai = 0; ai < 2; ++ai)
#pragma unroll
            for (int m = 0; m < 4; ++m) { const int n = row0 + ai * 128 + m * 16; bf16_t* rp;
                if (lat) rp = (n < 512 ? PP + (size_t)(b * 512 + n) * 4096 : n < 520 ? P64 + (size_t)(b * 8 + n - 512) * 4096 : PQ + (size_t)(b * 504 + n - 520) * 4096) + c0;
                else rp = PC + (size_t)(b * 1024 + n) * 256 + c0;
#pragma unroll
                for (int bj = 0; bj < 2; ++bj) st_bf8(rp + bj * 128, acc[ai][bj][m][0], acc[ai][bj][m][1]); }
    }
};
struct EpiDFTS {
    static constexpr bool PERM = true;
    bf16_t* F; float scale; int mode;
    __device__ __forceinline__ void operator()(const Acc& acc, const Unit& u, int wr, int wc, int fr_, int fq_) const {
        int fr = fr_, fq = fq_; asm volatile("" : "+v"(fr), "+v"(fq));
        const int r0 = wr * 64 + fr;
#pragma unroll
        for (int bj = 0; bj < 2; ++bj) { const int cl = wc * 32 + 8 * fq + bj * 128; int base; bool ok = true; float sgn = 1.f;
            if (mode == 0) { int bb, n;
                if (u.pn < 32) { const int c = u.pn * 256 + cl; bb = c >> 9; n = c & 511; }
                else { const int c = (u.pn - 32) * 256 + cl; ok = c < 8064; bb = c / 504; n = 520 + c - bb * 504; sgn = -1.f; }
                base = bb * (4096 * 1024) + n; }
            else if (mode == 1) { ok = (cl < 128) && (u.pn == 0); base = (cl >> 3) * (4096 * 1024) + 512 + (cl & 7); }
            else { const int c = u.pn * 256 + cl; const int bb = c >> 10, n = c & 1023; ok = (u.pm == 0) ? (n < 520) : (n >= 520); base = (NLAT + bb * 256) * 1024 + n; }
            if (ok) {
#pragma unroll
                for (int ai = 0; ai < 2; ++ai)
#pragma unroll
                    for (int m = 0; m < 4; ++m) { const f32x4 v0 = acc[ai][bj][m][0] * scale, v1 = acc[ai][bj][m][1] * scale; const int kk = r0 + ai * 128 + m * 16;
                        if (mode == 2) st_bf8_o(F, (unsigned)(base + kk * 1024), v0, v1);
                        else { const int k = 2 * ((u.pm & 3) * 256 + kk) + (u.pm >> 2); st_bf8_o(F, (unsigned)(base + k * 1024), v0, v1); if (k != 0) st_bf8_o(F, (unsigned)(base + (4096 - k) * 1024), v0 * sgn, v1 * sgn); } } }
            __builtin_amdgcn_sched_barrier(0); }
    }
};
struct EpiRes {
    static constexpr bool PERM = true;
    bf16_t* xb; const float* gate;
    float* part;
    __device__ __forceinline__ void operator()(const Acc& acc, const Unit& u, int wr, int wc, int fr_, int fq_) const {
        int fr = fr_, fq = fq_; asm volatile("" : "+v"(fr), "+v"(fq));
        if (part) { float* pp = part + ((size_t)u.ks * NCTX + u.pm * 256 + wr * 64 + fr) * 1024 + u.pn * 256 + wc * 32 + 8 * fq;
#pragma unroll
            for (int ai = 0; ai < 2; ++ai)
#pragma unroll
                for (int m = 0; m < 4; ++m)
#pragma unroll
                    for (int bj = 0; bj < 2; ++bj)
#pragma unroll
                        for (int n = 0; n < 2; ++n) *(f32x4*)(pp + (size_t)(ai * 128 + m * 16) * 1024 + bj * 128 + n * 4) = acc[ai][bj][m][n];
            return; }
        const int R0 = u.pm * 256; const int bidx = R0 < NLAT ? (R0 >> 12) : 16;
        const int r0 = wr * 64 + fr, col0 = u.pn * 256 + wc * 32 + 8 * fq; const float* gp = gate + bidx * 6144 + col0;
        const unsigned xo = (unsigned)((R0 + r0) * 1024 + col0);
        u32x4 xa[4], xq[4]; f32x4 g4[2][2];
#define RES_LOAD(X, BJ, AI) do { _Pragma("unroll") for (int m = 0; m < 4; ++m) X[m] = ld_bf8_o(xb, xo + (unsigned)(((AI) * 128 + m * 16) * 1024 + (BJ) * 128)); } while (0)
#define RES_PROC(X, BJ, AI) do { _Pragma("unroll") for (int m = 0; m < 4; ++m) { \
            const f32x4 x0 = (f32x4){bflo(X[m][0]), bfhi(X[m][0]), bflo(X[m][1]), bfhi(X[m][1])}, x1 = (f32x4){bflo(X[m][2]), bfhi(X[m][2]), bflo(X[m][3]), bfhi(X[m][3])}; \
            st_bf8_o(xb, xo + (unsigned)(((AI) * 128 + m * 16) * 1024 + (BJ) * 128), x0 + g4[BJ][0] * acc[AI][BJ][m][0], x1 + g4[BJ][1] * acc[AI][BJ][m][1]); } } while (0)
        RES_LOAD(xa, 0, 0);
#pragma unroll
        for (int bj = 0; bj < 2; ++bj)
#pragma unroll
            for (int n = 0; n < 2; ++n) g4[bj][n] = *(const f32x4*)(gp + bj * 128 + n * 4);
        RES_LOAD(xq, 0, 1); __builtin_amdgcn_sched_barrier(0);
        RES_PROC(xa, 0, 0); __builtin_amdgcn_sched_barrier(0);
        RES_LOAD(xa, 1, 0); __builtin_amdgcn_sched_barrier(0);
        RES_PROC(xq, 0, 1); __builtin_amdgcn_sched_barrier(0);
        RES_LOAD(xq, 1, 1); __builtin_amdgcn_sched_barrier(0);
        RES_PROC(xa, 1, 0); __builtin_amdgcn_sched_barrier(0);
        RES_PROC(xq, 1, 1);
#undef RES_LOAD
#undef RES_PROC
    }
};
__device__ __forceinline__ float gelu_tanh(float x) { const float z = 0.7978845608028654f * (x + 0.044715f * x * x * x); const float t = 1.f - 2.f * __builtin_amdgcn_rcpf(__expf(2.f * z) + 1.f); return 0.5f * x * (1.f + t); }
struct EpiLruIn {
    static constexpr bool PERM = true;
    bf16_t* G; bf16_t* XR;
    __device__ __forceinline__ void operator()(const Acc& acc, const Unit& u, int wr, int wc, int fr, int fq) const {
        const int row0 = u.pm * 256 + wr * 64 + fr; const int C0 = u.pn * 256; const bool isg = C0 < DRNN;
        bf16_t* base = isg ? G : XR; const int col0 = (isg ? C0 : C0 - DRNN) + wc * 32 + 8 * fq;
#pragma unroll
        for (int ai = 0; ai < 2; ++ai)
#pragma unroll
            for (int m = 0; m < 4; ++m) { bf16_t* rp = base + (size_t)(row0 + ai * 128 + m * 16) * DRNN + col0;
#pragma unroll
                for (int bj = 0; bj < 2; ++bj) { f32x4 v0 = acc[ai][bj][m][0], v1 = acc[ai][bj][m][1];
                    if (isg) {
#pragma unroll
                        for (int j = 0; j < 4; ++j) { v0[j] = gelu_tanh(v0[j]); v1[j] = gelu_tanh(v1[j]); } }
                    st_bf8(rp + bj * 128, v0, v1); } }
    }
};
struct EpiGate {
    static constexpr bool PERM = true;
    const bf16_t* XC; bf16_t* LA; bf16_t* U; const float* gpar;
    __device__ __forceinline__ void operator()(const Acc& acc, const Unit& u, int wr, int wc, int fr_, int fq_) const {
        int fr = fr_, fq = fq_; asm volatile("" : "+v"(fr), "+v"(fq));
        constexpr float L2E = 1.4426950408889634f;
        const int row0 = u.pm * 256 + wr * 64 + fr; const int ch0 = u.pn * 128 + wc * 32 + 8 * fq;
        u32x4 xall[2][4]; f32x4 ba4[2], bx4[2], sp4[2];
#pragma unroll
        for (int n = 0; n < 2; ++n) { ba4[n] = *(const f32x4*)(gpar + ch0 + n * 4); bx4[n] = *(const f32x4*)(gpar + DRNN + ch0 + n * 4); sp4[n] = *(const f32x4*)(gpar + 2 * DRNN + ch0 + n * 4); }
#pragma unroll
        for (int ai = 0; ai < 2; ++ai)
#pragma unroll
            for (int m = 0; m < 4; ++m) xall[ai][m] = ld_bf8_o(XC, (unsigned)((row0 + ai * 128 + m * 16) * DRNN + ch0));
        __builtin_amdgcn_sched_barrier(0);
#pragma unroll
        for (int ai = 0; ai < 2; ++ai)
#pragma unroll
            for (int m = 0; m < 4; ++m) { const unsigned o = (unsigned)((row0 + ai * 128 + m * 16) * DRNN + ch0); const u32x4 xw = xall[ai][m];
                u32x4 wl, wu;
#pragma unroll
                for (int n = 0; n < 2; ++n)
#pragma unroll
                    for (int jp = 0; jp < 2; ++jp) { float l2[2], u2[2];
#pragma unroll
                        for (int q = 0; q < 2; ++q) { const int j = jp * 2 + q; const unsigned xwd = xw[2 * n + jp]; const float xv = q ? bfhi(xwd) : bflo(xwd);
                            const float r = __builtin_amdgcn_rcpf(1.f + __builtin_amdgcn_exp2f(fmaf(acc[ai][0][m][n][j], -L2E, ba4[n][j])));
                            const float ig = __builtin_amdgcn_rcpf(1.f + __builtin_amdgcn_exp2f(fmaf(acc[ai][1][m][n][j], -L2E, bx4[n][j])));
                            l2[q] = r * sp4[n][j]; u2[q] = ig * xv; }
                        wl[2 * n + jp] = cvtpk(l2[0], l2[1]); wu[2 * n + jp] = cvtpk(u2[0], u2[1]); }
                *(u32x4*)((char*)LA + (size_t)(o * 2u)) = wl; *(u32x4*)((char*)U + (size_t)(o * 2u)) = wu; }
    }
};

struct EpiQKV {
    static constexpr bool PERM = true;
    bf16_t* Q; bf16_t* KB; bf16_t* VB; const float* qg; const float* kg; const float* rope; LAS float* red;
    __device__ __forceinline__ void operator()(const Acc& acc, const Unit& u, int wr, int wc, int fr_, int fq_) const {
        int fr = fr_, fq = fq_; asm volatile("" : "+v"(fr), "+v"(fq));
        const int R0 = u.pm * 256; const bool lat = R0 < NLAT; const int r0 = wr * 64 + fr; const int cw = wc * 32 + 8 * fq;
        const int krow0 = lat ? (R0 >> 12) * SKV + (R0 & 4095) : ((R0 - NLAT) >> 8) * SKV + SEQ;
        if (u.pn == 5) {
#pragma unroll
            for (int ai = 0; ai < 2; ++ai)
#pragma unroll
                for (int m = 0; m < 4; ++m) { bf16_t* vp = VB + (size_t)(krow0 + r0 + ai * 128 + m * 16) * 256 + cw;
#pragma unroll
                    for (int bj = 0; bj < 2; ++bj) st_bf8(vp + bj * 128, acc[ai][bj][m][0], acc[ai][bj][m][1]); }
            return; }
        const int lane = fr | (fq << 4);
#pragma unroll
        for (int ai = 0; ai < 2; ++ai)
#pragma unroll
            for (int m = 0; m < 4; ++m)
#pragma unroll
                for (int bj = 0; bj < 2; ++bj) { float sq = 0.f;
#pragma unroll
                    for (int n = 0; n < 2; ++n) { const f32x4 a = acc[ai][bj][m][n]; sq += a[0] * a[0] + a[1] * a[1] + a[2] * a[2] + a[3] * a[3]; }
                    sq += lane_xor(sq, lane, 16); sq += lane_xor(sq, lane, 32);
                    if (fq == 0) red[((r0 + ai * 128 + m * 16) * 2 + bj) * 4 + wc] = sq; }
        asm volatile("s_waitcnt lgkmcnt(0)" ::: "memory"); __builtin_amdgcn_s_barrier(); asm volatile("" ::: "memory");
        const float* gsel = (u.pn < 4 ? qg : kg) + cw; const f32x4 g4[2] = {*(const f32x4*)gsel, *(const f32x4*)(gsel + 4)};
        const int jb = (wc & 1) * 16 + 4 * fq;
#pragma unroll
        for (int ai = 0; ai < 2; ++ai) {
            f32x4 cs[4][2];
#pragma unroll
            for (int m = 0; m < 4; ++m) { const int t = (R0 + r0 + ai * 128 + m * 16) & 4095; const int pos = (wc < 2) ? (t >> 6) : (t & 63);
#pragma unroll
                for (int n = 0; n < 2; ++n) cs[m][n] = lat ? *(const f32x4*)(rope + (size_t)(pos * 32 + jb + 2 * n) * 2) : (f32x4){1.f, 0.f, 1.f, 0.f}; }
            __builtin_amdgcn_sched_barrier(0);
#pragma unroll
            for (int m = 0; m < 4; ++m) { const int row = r0 + ai * 128 + m * 16;
#pragma unroll
                for (int bj = 0; bj < 2; ++bj) { const f32x4 q = *(const LAS f32x4*)(red + (row * 2 + bj) * 4); const float rs = rsqrtf(((q[0] + q[1]) + (q[2] + q[3])) * (1.f / 128.f) + 1e-6f);
                    f32x4 y[2];
#pragma unroll
                    for (int n = 0; n < 2; ++n) { const f32x4 c4 = cs[m][n]; const f32x4 v = acc[ai][bj][m][n] * rs * g4[n];
                        y[n] = (f32x4){v[0] * c4[0] - v[1] * c4[1], v[0] * c4[1] + v[1] * c4[0], v[2] * c4[2] - v[3] * c4[3], v[2] * c4[3] + v[3] * c4[2]}; }
                    bf16_t* dp = (u.pn < 4) ? Q + (size_t)(R0 + row) * 1024 + u.pn * 256 + bj * 128 + cw : KB + (size_t)(krow0 + row) * 256 + bj * 128 + cw;
                    st_bf8(dp, y[0], y[1]); } }
            __builtin_amdgcn_sched_barrier(0); }
    }
};

template <class Epi, class Order = pg8::StaticOrder>
__device__ __forceinline__ void run_gemm(const int wv, LAS unsigned char* lds, const bf16_t* A, int lda, const bf16_t* Bt, int M, int N, int K, const Epi& E) {
    Order S; S.init(M, N, (int)gridDim.x, (int)blockIdx.x);
    pg8::Gemm g; g.A = A; g.Bt = Bt; g.M = M; g.N = N; g.K = K; g.lda = lda; g.ldb = K;
    pg8::gemm_phase<Epi, Order>(wv, lds, g, S, E);
}

namespace at {
constexpr int D = 128, NW = 8, QBLK = 32, KVBLK = 64;
constexpr float SCALE = 0.088388347648318440f, THR = 8.f;
constexpr int LDQ = 1024, LDK = 256, LDO = 1024;
constexpr size_t SHM_V = KVBLK * D * 2, SHM_K = KVBLK * D * 2;
#define KSWZ(row, colB) ((row) * 256 + ((colB) ^ (((row) & 7) << 4)))
#define SBAR() __builtin_amdgcn_sched_barrier(0)
__device__ __forceinline__ int crow(int r, int hi) { return (r & 3) + 8 * (r >> 2) + 4 * hi; }
__device__ __forceinline__ void partialSM(f32x16& p0, f32x16& p1, float& m_reg, float& mn, float& alpha) {
    constexpr float C = SCALE * 1.4426950408889634f;
    float pmax = p0[0];
#pragma unroll
    for (int r = 1; r < 16; ++r) pmax = fmaxf(pmax, p0[r]);
#pragma unroll
    for (int r = 0; r < 16; ++r) pmax = fmaxf(pmax, p1[r]);
    { auto rr = __builtin_amdgcn_permlane32_swap(__float_as_uint(pmax), __float_as_uint(pmax), false, false);
      pmax = fmaxf(__uint_as_float(rr[0]), __uint_as_float(rr[1])); }
    if (__builtin_expect(__all(pmax - m_reg <= THR / SCALE), 1)) { mn = m_reg; alpha = 1.f; }
    else { mn = fmaxf(m_reg, pmax); alpha = __builtin_amdgcn_exp2f((m_reg - mn) * C); m_reg = mn; }
    float mnC = -mn * C;
#pragma unroll
    for (int r = 0; r < 16; ++r) p0[r] = fmaf(p0[r], C, mnC);
#pragma unroll
    for (int r = 0; r < 16; ++r) p1[r] = fmaf(p1[r], C, mnC);
#pragma unroll
    for (int r = 0; r < 16; ++r) p0[r] = __builtin_amdgcn_exp2f(p0[r]);
}
__device__ __forceinline__ void finishSM(f32x16& p0, f32x16& p1, float alpha, float& l_reg, bf16x8& pa0, bf16x8& pa1, bf16x8& pa2, bf16x8& pa3) {
#pragma unroll
    for (int r = 0; r < 16; ++r) p1[r] = __builtin_amdgcn_exp2f(p1[r]);
    float ps = 0;
#pragma unroll
    for (int r = 0; r < 16; ++r) ps += p0[r];
#pragma unroll
    for (int r = 0; r < 16; ++r) ps += p1[r];
    { auto rr = __builtin_amdgcn_permlane32_swap(__float_as_uint(ps), __float_as_uint(ps), false, false);
      ps = __uint_as_float(rr[0]) + __uint_as_float(rr[1]); }
    l_reg = l_reg * alpha + ps;
#define PK4(P, BASE, OUT) do { unsigned a0 = cvtpk(P[BASE + 0], P[BASE + 1]), a1 = cvtpk(P[BASE + 2], P[BASE + 3]);   \
    unsigned b0 = cvtpk(P[BASE + 4], P[BASE + 5]), b1 = cvtpk(P[BASE + 6], P[BASE + 7]);                              \
    auto r0 = __builtin_amdgcn_permlane32_swap(a0, b0, false, false); auto r1 = __builtin_amdgcn_permlane32_swap(a1, b1, false, false); \
    u32x4 w = {r0[0], r1[0], r0[1], r1[1]}; OUT = *reinterpret_cast<bf16x8*>(&w); } while (0)
    PK4(p0, 0, pa0); PK4(p0, 8, pa1); PK4(p1, 0, pa2); PK4(p1, 8, pa3);
#undef PK4
}
__device__ __forceinline__ void qkt(f32x16& p0, f32x16& p1, const bf16_t* Ks, const bf16x8* qr, int r32, int hi) {
    p0 = f32x16{}; p1 = f32x16{};
#pragma unroll
    for (int d0 = 0; d0 < 8; ++d0) { int cb = (d0 * 16 + hi * 8) * 2;
        bf16x8 b0 = *reinterpret_cast<const bf16x8*>((const char*)Ks + KSWZ(r32, cb));
        bf16x8 b1 = *reinterpret_cast<const bf16x8*>((const char*)Ks + KSWZ(32 + r32, cb));
        p0 = __builtin_amdgcn_mfma_f32_32x32x16_bf16(b0, qr[d0], p0, 0, 0, 0);
        p1 = __builtin_amdgcn_mfma_f32_32x32x16_bf16(b1, qr[d0], p1, 0, 0, 0); }
}
__device__ __forceinline__ int v_st(int k, int c) { const int kk = (k & ~0xC) | ((k & 4) << 1) | ((k & 8) >> 1); return ((kk >> 3) * 4 + (c >> 5)) * 512 + ((kk & 7) * 32 + (c & 31)) * 2; }
__device__ __forceinline__ int v_rd_base(int lane) { return ((lane & 3) << 3) | (((lane >> 2) & 3) << 6) | (((lane >> 4) & 1) << 5) | (((lane >> 5) & 1) << 8); }
constexpr int v_rd_off(int d0, int ks, int half) { return d0 * 512 + ks * 4096 + half * 2048; }
template <int OFF> __device__ __forceinline__ s16x4 tr_read(int vb) {
    s16x4 r; asm volatile("ds_read_b64_tr_b16 %0, %1 offset:%2" : "=&v"(r) : "v"(vb), "i"(OFF) : "memory"); return r;
}
template <int D0> __device__ __forceinline__ void pv_one(f32x16& od, int vb, bf16x8 pa0, bf16x8 pa1, bf16x8 pa2, bf16x8 pa3) {
    const s16x4 l0 = tr_read<v_rd_off(D0, 0, 0)>(vb), h0 = tr_read<v_rd_off(D0, 0, 1)>(vb), l1 = tr_read<v_rd_off(D0, 1, 0)>(vb), h1 = tr_read<v_rd_off(D0, 1, 1)>(vb);
    const s16x4 l2 = tr_read<v_rd_off(D0, 2, 0)>(vb), h2 = tr_read<v_rd_off(D0, 2, 1)>(vb), l3 = tr_read<v_rd_off(D0, 3, 0)>(vb), h3 = tr_read<v_rd_off(D0, 3, 1)>(vb);
    asm volatile("s_waitcnt lgkmcnt(0)" ::: "memory"); SBAR();
#define PK(L, H) (bf16x8){L[0], L[1], L[2], L[3], H[0], H[1], H[2], H[3]}
    od = __builtin_amdgcn_mfma_f32_32x32x16_bf16(pa0, PK(l0, h0), od, 0, 0, 0);
    od = __builtin_amdgcn_mfma_f32_32x32x16_bf16(pa1, PK(l1, h1), od, 0, 0, 0);
    od = __builtin_amdgcn_mfma_f32_32x32x16_bf16(pa2, PK(l2, h2), od, 0, 0, 0);
    od = __builtin_amdgcn_mfma_f32_32x32x16_bf16(pa3, PK(l3, h3), od, 0, 0, 0);
#undef PK
}
__device__ __forceinline__ void pv_d0(f32x16* o, int vb, bf16x8 pa0, bf16x8 pa1, bf16x8 pa2, bf16x8 pa3) {
    pv_one<0>(o[0], vb, pa0, pa1, pa2, pa3); pv_one<1>(o[1], vb, pa0, pa1, pa2, pa3); pv_one<2>(o[2], vb, pa0, pa1, pa2, pa3); pv_one<3>(o[3], vb, pa0, pa1, pa2, pa3);
}
__device__ __forceinline__ void attn_dense_body(const int wv, const bf16_t* __restrict__ Qb, const bf16_t* __restrict__ Kh, const bf16_t* __restrict__ Vh,
                                                bf16_t* __restrict__ Ob, int seq, char* lds) {
    const int tid = ltid(wv), wid = tid >> 6, lane = tid & 63, r32 = lane & 31, hi = lane >> 5;
    bf16_t* V_lds = (bf16_t*)lds; bf16_t* K_lds = (bf16_t*)(lds + 2 * SHM_V);
    float* ws = (float*)(lds + 2 * SHM_V + 2 * SHM_K) + wid * 64; float* li_l = ws; float* al_l = ws + 32;
    float m_reg = -1e30f, l_reg = 0; f32x16 o[4] = {}; bf16x8 qr[8];
    const bf16_t* Qw = Qb + (long)(wid * QBLK + r32) * LDQ + hi * 8;
#pragma unroll
    for (int d0 = 0; d0 < 8; ++d0) qr[d0] = *reinterpret_cast<const bf16x8*>(Qw + d0 * 16);
    const int sr = tid >> 4, sc = (tid & 15) * 8, vst0 = v_st(sr, sc), vst1 = v_st(32 + sr, sc);
    const int vb0 = (int)(uintptr_t)V_lds + v_rd_base(lane);
    struct { bf16x8 vs0, vs1, ks0, ks1; } sr_[2];
#define SLOAD(i, k0) do { sr_[i].vs0 = *reinterpret_cast<const bf16x8*>(&Vh[(long)((k0) + sr) * LDK + sc]); sr_[i].vs1 = *reinterpret_cast<const bf16x8*>(&Vh[(long)((k0) + 32 + sr) * LDK + sc]); \
    sr_[i].ks0 = *reinterpret_cast<const bf16x8*>(&Kh[(long)((k0) + sr) * LDK + sc]); sr_[i].ks1 = *reinterpret_cast<const bf16x8*>(&Kh[(long)((k0) + 32 + sr) * LDK + sc]); } while (0)
#define SWRITE(b, i) do { *(bf16x8*)((char*)V_lds + (b) * SHM_V + vst0) = sr_[i].vs0;          \
    *(bf16x8*)((char*)V_lds + (b) * SHM_V + vst1) = sr_[i].vs1; int kc = sc * 2;               \
    *(bf16x8*)((char*)K_lds + (b) * SHM_K + KSWZ(sr, kc)) = sr_[i].ks0;                       \
    *(bf16x8*)((char*)K_lds + (b) * SHM_K + KSWZ(32 + sr, kc)) = sr_[i].ks1; } while (0)
#define SWAIT() asm volatile("s_waitcnt vmcnt(4)" ::: "memory")
#define RESC(a) do { if (__any((a) < 1.f)) { if (hi == 0) al_l[r32] = (a); asm volatile("s_waitcnt lgkmcnt(0)" ::: "memory"); \
    _Pragma("unroll") for (int d = 0; d < 4; ++d) _Pragma("unroll") for (int r = 0; r < 16; ++r) o[d][r] *= al_l[crow(r, hi)]; } } while (0)
    f32x16 pA0, pA1, pB0, pB1; float mnA, mnB, alA, alB; bf16x8 pa0, pa1, pa2, pa3; const int NT = seq / KVBLK;
    constexpr int SE = 0, SO = 1;
    SLOAD(SE, 0); asm volatile("s_waitcnt vmcnt(0)" ::: "memory"); SWRITE(0, SE); __syncthreads();
    qkt(pA0, pA1, K_lds, qr, r32, hi); partialSM(pA0, pA1, m_reg, mnA, alA);
    SLOAD(SO, KVBLK); if (2 < NT) SLOAD(SE, 2 * KVBLK);
    SWAIT(); SWRITE(1, SO); __syncthreads();
    for (int j = 1; j + 1 < NT; j += 2) {
        SBAR(); qkt(pB0, pB1, (bf16_t*)((char*)K_lds + SHM_K), qr, r32, hi);
        finishSM(pA0, pA1, alA, l_reg, pa0, pa1, pa2, pa3); SBAR();
        SLOAD(SO, (j + 2) * KVBLK); SBAR();
        pv_d0(o, vb0, pa0, pa1, pa2, pa3); partialSM(pB0, pB1, m_reg, mnB, alB);
        __syncthreads(); SWAIT(); SWRITE(0, SE);
        RESC(alB); __syncthreads();
        SBAR(); qkt(pA0, pA1, K_lds, qr, r32, hi);
        finishSM(pB0, pB1, alB, l_reg, pa0, pa1, pa2, pa3); SBAR();
        if (j + 3 < NT) SLOAD(SE, (j + 3) * KVBLK); SBAR();
        pv_d0(o, vb0 + (int)SHM_V, pa0, pa1, pa2, pa3); partialSM(pA0, pA1, m_reg, mnA, alA);
        __syncthreads(); SWAIT(); SWRITE(1, SO);
        RESC(alA); __syncthreads();
    }
    SBAR(); qkt(pB0, pB1, (bf16_t*)((char*)K_lds + SHM_K), qr, r32, hi);
    finishSM(pA0, pA1, alA, l_reg, pa0, pa1, pa2, pa3); SBAR();
    pv_d0(o, vb0, pa0, pa1, pa2, pa3); partialSM(pB0, pB1, m_reg, mnB, alB);
    __syncthreads(); RESC(alB);
    finishSM(pB0, pB1, alB, l_reg, pa0, pa1, pa2, pa3); SBAR();
    pv_d0(o, vb0 + (int)SHM_V, pa0, pa1, pa2, pa3);
    if (hi == 0) li_l[r32] = l_reg; asm volatile("s_waitcnt lgkmcnt(0)" ::: "memory");
    float rli[16];
#pragma unroll
    for (int r = 0; r < 16; ++r) rli[r] = __builtin_amdgcn_rcpf(li_l[crow(r, hi)]);
    bf16_t* Ow = Ob + (long)(wid * QBLK) * LDO;
#pragma unroll
    for (int r = 0; r < 16; ++r) { int orow = crow(r, hi);
#pragma unroll
        for (int d0 = 0; d0 < 4; ++d0) Ow[(long)orow * LDO + d0 * 32 + r32] = f2bf(o[d0][r] * rli[r]); }
#undef SLOAD
#undef SWRITE
#undef SWAIT
#undef RESC
}
}

template <bool FW = false>
__device__ __forceinline__ void tr_job(const int wv, const float* __restrict__ src, bf16_t* __restrict__ dst, int K, int N, float* t, int& off) {
    const int G = gridDim.x, tid = ltid(wv); const int tn = N / 64, ntiles = (K / 64) * tn;
    int first = ((int)blockIdx.x - (off % G) + G) % G;
    for (int tile = first; tile < ntiles; tile += G) {
        const int k0 = (tile / tn) * 64, n0 = (tile % tn) * 64;
        { const int kk = tid >> 4, c4 = (tid & 15) * 4;
#pragma unroll
          for (int h = 0; h < 2; ++h) { f32x4 v;
              if (!FW) v = *(const f32x4*)(src + (size_t)(k0 + kk + h * 32) * N + n0 + c4);
              else { const int n = k0 + kk + h * 32; int r1, r2; float s2 = 1.f;
                  if (n < 512) { const int g = n >> 6, l = n & 63; r1 = g * 128 + l; r2 = l ? g * 128 + 128 - l : -1; }
                  else if (n < 520) { r1 = (n - 512) * 128 + 64; r2 = -1; }
                  else { const int q = n - 520; const int g = q / 63, l = q - g * 63 + 1; r1 = g * 128 + 128 - l; r2 = g * 128 + l; s2 = -1.f; }
                  v = *(const f32x4*)(src + (size_t)r1 * N + n0 + c4);
                  if (r2 >= 0) v += *(const f32x4*)(src + (size_t)r2 * N + n0 + c4) * s2; }
              float* tp = t + (kk + h * 32) * 65 + c4; tp[0] = v[0]; tp[1] = v[1]; tp[2] = v[2]; tp[3] = v[3]; } }
        __syncthreads();
        { const int nn = tid >> 3, kc = (tid & 7) * 8; float v[8];
#pragma unroll
          for (int j = 0; j < 8; ++j) v[j] = t[(kc + j) * 65 + nn];
          u32x4 w = {cvtpk(v[0], v[1]), cvtpk(v[2], v[3]), cvtpk(v[4], v[5]), cvtpk(v[6], v[7])};
          *(u32x4*)(dst + (size_t)(n0 + nn) * K + k0 + kc) = w; }
        __syncthreads();
    }
    off += ntiles;
}

typedef const __attribute__((address_space(4))) Params* PP;
__device__ __forceinline__ void prep_phase(const int wv, PP p, char* lds) {
    const int tid = ltid(wv), lane = tid & 63, wid = tid >> 6, G = gridDim.x, bid = blockIdx.x;
    unsigned char* ws = p->ws;
    {
        float* sT = (float*)lds; float* red = (float*)(lds + 81920);
        for (int idx = tid; idx < 20 * 1024; idx += 512) { const int r = idx >> 10, k = idx & 1023; float v = 0.f;
            if (r < 17) { const float cv = r < 16 ? p->c[r * 1024 + k] : p->c_ctx[k]; v = cv / (1.f + __expf(-cv)); }
            sT[k * 20 + r] = v; }
        __syncthreads();
        for (int task = bid; task < 192; task += G) {
            const int layer = task / 48, chunk = task % 48; const int colw = tid & 127, kg = tid >> 7, n = chunk * 128 + colw;
            float acc[17];
#pragma unroll
            for (int r = 0; r < 17; ++r) acc[r] = 0.f;
            const float* wp = p->ada_w + ((size_t)layer * 1024 + kg * 256) * 6144 + n;
#pragma unroll 16
            for (int k = 0; k < 256; ++k) { const float w = wp[(size_t)k * 6144]; const float* sp = sT + (kg * 256 + k) * 20;
                const f32x4 s0 = *(const f32x4*)sp, s1 = *(const f32x4*)(sp + 4), s2 = *(const f32x4*)(sp + 8), s3 = *(const f32x4*)(sp + 12); const float s16 = sp[16];
#pragma unroll
                for (int j = 0; j < 4; ++j) { acc[j] += s0[j] * w; acc[4 + j] += s1[j] * w; acc[8 + j] += s2[j] * w; acc[12 + j] += s3[j] * w; }
                acc[16] += s16 * w; }
#pragma unroll
            for (int r = 0; r < 17; ++r) red[(kg * 17 + r) * 128 + colw] = acc[r];
            __syncthreads();
            for (int idx = tid; idx < 17 * 128; idx += 512) { const int r = idx >> 7, cw = idx & 127; const int nn = chunk * 128 + cw;
                const float s = red[(0 * 17 + r) * 128 + cw] + red[(1 * 17 + r) * 128 + cw] + red[(2 * 17 + r) * 128 + cw] + red[(3 * 17 + r) * 128 + cw] + p->ada_b[layer * 6144 + nn];
                ((float*)(ws + O_MOD))[((size_t)layer * 17 + r) * 6144 + nn] = s; }
            __syncthreads();
        }
        __syncthreads();
    }
    {
        float* t = (float*)lds; int off = 0;
        for (int l = 0; l < 4; ++l) {
            tr_job(wv, p->mlp_w1 + (size_t)l * 1024 * 4096, (bf16_t*)(ws + O_W1T) + (size_t)l * 4096 * 1024, 1024, 4096, t, off);
            tr_job(wv, p->mlp_w2 + (size_t)l * 4096 * 1024, (bf16_t*)(ws + O_W2T) + (size_t)l * 1024 * 4096, 4096, 1024, t, off);
        }
        for (int j = 0; j < 2; ++j) tr_job<true>(wv, p->fnet_w_out + (size_t)j * 1024 * 1024, (bf16_t*)(ws + O_FWOT) + (size_t)j * 1024 * 1024, 1024, 1024, t, off);
        tr_job(wv, p->attn_w_qkv, (bf16_t*)(ws + O_WQKVT), 1024, 1536, t, off);
        tr_job(wv, p->attn_w_o, (bf16_t*)(ws + O_WOT), 1024, 1024, t, off);
        tr_job(wv, p->lru_w_in, (bf16_t*)(ws + O_LWINT), 1024, 2560, t, off);
        tr_job(wv, p->lru_w_out, (bf16_t*)(ws + O_LWOT), 1280, 1024, t, off);
    }
    {
        float* wt = (float*)lds; float* tab = (float*)(lds + 64 * 129 * 4);
        for (int task = bid; task < 256; task += G) {
            const int j = task >> 7, g = (task >> 4) & 7, k0 = (task & 15) * 64;
            if (tid < 128) tab[tid] = cospif((float)tid * (1.f / 64.f));
#pragma unroll
            for (int i = 0; i < 4; ++i) { const int idx = tid + i * 512; const int row = idx >> 5, c4 = (idx & 31) * 4;
                const f32x4 v = *(const f32x4*)(p->fnet_w_in + ((size_t)j * 1024 + k0 + row) * 1024 + g * 128 + c4); float* tp = wt + row * 129 + c4; tp[0] = v[0]; tp[1] = v[1]; tp[2] = v[2]; tp[3] = v[3]; }
            __syncthreads();
            bf16_t* dstb = (bf16_t*)(ws + O_WPQT) + (size_t)j * 1024 * 1024;
            for (int ii = 0; ii < 16; ++ii) { const int i = wid * 16 + ii; const int sf = i > 64 ? 1 : 0; const int l = sf ? i - 64 : i;
                const int n = sf ? 520 + g * 63 + l - 1 : (l < 64 ? g * 64 + l : 512 + g);
                float acc = 0.f; const float* wr_ = wt + lane * 129;
#pragma unroll 8
                for (int c = 0; c < 128; ++c) acc += wr_[c] * tab[(l * c - sf * 32) & 127];
                dstb[(size_t)n * 1024 + k0 + lane] = f2bf(acc); }
            __syncthreads();
        }
    }
    { float* gp = (float*)(ws + O_GPAR); for (int i = bid * 512 + tid; i < 2 * DRNN; i += G * 512) { const int d = i / DRNN, c = i - d * DRNN;
        gp[(d * 3 + 0) * DRNN + c] = p->ga_b[i] * -1.4426950408889634f; gp[(d * 3 + 1) * DRNN + c] = p->gx_b[i] * -1.4426950408889634f; gp[(d * 3 + 2) * DRNN + c] = -8.f * __logf(1.f + __expf(-p->lam[i])); } }
    { float* rt = (float*)(ws + O_ROPE); for (int i = bid * 512 + tid; i < 2048; i += G * 512) { const int pos = i >> 5, j = i & 31; const float inv = powf(10000.f, -(float)j * (1.f / 32.f)); float sn, cs; sincosf((float)pos * inv, &sn, &cs); rt[i * 2] = cs; rt[i * 2 + 1] = sn; } }
    {
        bf16_t* gt = (bf16_t*)(ws + O_GATET);
        for (int idx = bid * 512 + tid; idx < 2 * 2560 * 256; idx += G * 512) {
            const int d = idx / (2560 * 256); const int rem = idx - d * 2560 * 256; const int n = rem >> 8, k = rem & 255;
            const int blk = n >> 8, half = (n >> 7) & 1, jout = n & 127, kq = k >> 7, i = k & 127; float v = 0.f;
            if (kq == (blk & 1)) v = (half ? p->gx_w : p->ga_w)[(((size_t)d * 10 + blk) * 128 + i) * 128 + jout];
            gt[idx] = f2bf(v); }
    }
    {
        bf16_t* d2 = (bf16_t*)(ws + O_D256);
        for (int idx = bid * 512 + tid; idx < 512 * 256; idx += G * 512) { const int r = idx >> 8, t = idx & 255; const float a = (float)(((r & 255) * t) & 255) * (1.f / 128.f);
            d2[idx] = f2bf(r < 256 ? cospif(a) : sinpif(a)); }
    }
}

__device__ __forceinline__ void dmat_gen(const int wv, bf16_t* dm, char* lds) {
    float* tab = (float*)lds; const int tid = ltid(wv);
    for (int i = tid; i < 4096; i += 512) tab[i] = cospif((float)i * (1.f / 2048.f));
    __syncthreads();
    constexpr int VR = KF / 8;
    for (int idx = blockIdx.x * 512 + tid; idx < 4096 * VR; idx += gridDim.x * 512) { const int row = idx / VR, v = idx - row * VR; const int type = row >> 11, cls = (row >> 10) & 1, k = 2 * (row & 1023) + cls; const int t0 = v * 8; const int sh = type ? 3072 : 0;
        float f[8];
#pragma unroll
        for (int e = 0; e < 8; ++e) f[e] = (t0 + e <= 1024) ? tab[(k * (t0 + e) + sh) & 4095] : 0.f;
        u32x4 w = {cvtpk(f[0], f[1]), cvtpk(f[2], f[3]), cvtpk(f[4], f[5]), cvtpk(f[6], f[7])};
        *(u32x4*)(dm + (size_t)idx * 8) = w; }
    __syncthreads();
}
__device__ __forceinline__ void fold_phase(const int wv, const bf16_t* __restrict__ src, bf16_t* __restrict__ dst) {
    const int tid = ltid(wv); const int lane = tid & 63, wid = tid >> 6; const int gwv = blockIdx.x * 8 + wid, nwv = gridDim.x * 8;
    for (int r = gwv; r < 16640; r += nwv) { const bf16_t* rp = src + (size_t)r * 4096; bf16_t* wE = dst + (size_t)r * KF; bf16_t* wO = dst + (size_t)(16640 + r) * KF;
        const bool isq = (r >= 8192 && r < 16384); const float sg = isq ? -1.f : 1.f;
        u32x4 a1[2], a2[2], g1[2], h1[2]; bf16_t gx[2], hx[2];
#pragma unroll
        for (int i = 0; i < 2; ++i) { const int t0 = i * 512 + lane * 8; a1[i] = *(const u32x4*)(rp + t0); a2[i] = *(const u32x4*)(rp + 2048 + t0); g1[i] = *(const u32x4*)(rp + 2040 - t0); h1[i] = *(const u32x4*)(rp + 4088 - t0);
            gx[i] = rp[2048 - t0]; hx[i] = rp[t0 ? 4096 - t0 : 0]; }
        const float x1024 = bf1(rp[1024]) + sg * bf1(rp[3072]);
#pragma unroll
        for (int i = 0; i < 2; ++i) { const int t0 = i * 512 + lane * 8;
#define UNPK(W) {bflo(W[0]), bfhi(W[0]), bflo(W[1]), bfhi(W[1]), bflo(W[2]), bfhi(W[2]), bflo(W[3]), bfhi(W[3])}
            const float xa[8] = UNPK(a1[i]); const float xb2[8] = UNPK(a2[i]); const float yg[8] = UNPK(g1[i]); const float yh[8] = UNPK(h1[i]);
#undef UNPK
            float oe[8], oo[8];
#pragma unroll
            for (int e = 0; e < 8; ++e) { const bool t_is0 = (e == 0) && (t0 == 0);
                const float p_t = xa[e], p_2048pt = t_is0 ? 0.f : xb2[e];
                const float p_2048mt = e ? yg[8 - e] : bf1(gx[i]);
                const float p_4096mt = t_is0 ? 0.f : (e ? yh[8 - e] : bf1(hx[i]));
                const float s1 = p_t + sg * p_4096mt, s2 = p_2048mt + sg * p_2048pt;
                oe[e] = s1 + sg * s2; oo[e] = s1 - sg * s2; }
            const u32x4 we = {cvtpk(oe[0], oe[1]), cvtpk(oe[2], oe[3]), cvtpk(oe[4], oe[5]), cvtpk(oe[6], oe[7])};
            const u32x4 wo = {cvtpk(oo[0], oo[1]), cvtpk(oo[2], oo[3]), cvtpk(oo[4], oo[5]), cvtpk(oo[6], oo[7])};
            *(u32x4*)(wE + t0) = we; *(u32x4*)(wO + t0) = wo; }
        const unsigned x16 = cvtpk(x1024, 0.f) & 0xffffu;
        *(unsigned*)(wE + 1024 + lane * 2) = (lane == 0 && !isq) ? x16 : 0u;
        *(unsigned*)(wO + 1024 + lane * 2) = (lane == 0 && isq) ? x16 : 0u;
    }
}
__device__ __forceinline__ void nyquist_pass(const int wv, const bf16_t* PP, const bf16_t* P64, bf16_t* F, float scale) {
    const int tid = ltid(wv); const int lane = tid & 63, wid = tid >> 6; const int gwv = blockIdx.x * 8 + wid, nwv = gridDim.x * 8;
    for (int r = gwv; r < 8192 + 128; r += nwv) { const bf16_t* src; int b, n;
        if (r < 8192) { src = PP + (size_t)r * 4096; b = r >> 9; n = r & 511; } else { const int rr = r - 8192; src = P64 + (size_t)rr * 4096; b = rr >> 3; n = 512 + (rr & 7); }
        float sacc = 0.f;
#pragma unroll
        for (int i = 0; i < 8; ++i) { const u32x4 w = *(const u32x4*)(src + i * 512 + lane * 8);
            sacc += (bflo(w[0]) - bfhi(w[0])) + (bflo(w[1]) - bfhi(w[1])) + (bflo(w[2]) - bfhi(w[2])) + (bflo(w[3]) - bfhi(w[3])); }
        sacc = wave_sum(sacc, lane);
        if (lane == 0) F[((size_t)b * 4096 + 2048) * 1024 + n] = f2bf(sacc * scale); }
    for (int idx = blockIdx.x * 512 + tid; idx < 16 * 504; idx += gridDim.x * 512) { const int b = idx / 504, q = idx - b * 504; F[((size_t)b * 4096 + 2048) * 1024 + 520 + q] = 0; }
}

template <bool F32IN>
__device__ __forceinline__ void norm_phase(const int wv, const float* __restrict__ xl, const float* __restrict__ xc, bf16_t* xb, const float* __restrict__ gw, const float* __restrict__ mod, int shoff, int scoff, bf16_t* __restrict__ H, int nrows,
                                           const float* __restrict__ part = nullptr, const float* __restrict__ pgate = nullptr) {
    const int tid = ltid(wv); const int lane = tid & 63, wid = tid >> 6; const int gwv = blockIdx.x * 8 + wid, nwv = gridDim.x * 8; const int ntask = nrows / 8;
    for (int task = gwv; task < ntask; task += nwv) {
        const int row0 = task * 8; const int bidx = row0 < NLAT ? (row0 >> 12) : 16; const float* mrow = mod + bidx * 6144;
        const float* src0 = (row0 < NLAT ? xl + (size_t)row0 * 1024 : xc + (size_t)(row0 - NLAT) * 1024) + lane * 4;
        bf16_t* xr0 = xb + (size_t)row0 * 1024 + lane * 4;
        f32x4 mul[4], add[4];
#pragma unroll
        for (int j = 0; j < 4; ++j) { const int col = j * 256 + lane * 4; const f32x4 g4 = *(const f32x4*)(gw + col), sc4 = *(const f32x4*)(mrow + scoff + col); add[j] = *(const f32x4*)(mrow + shoff + col); mul[j] = g4 * (sc4 + 1.f); }
#pragma unroll
        for (int hb = 0; hb < 2; ++hb) {
            f32x4 v[4][4];
            if (F32IN) {
#pragma unroll
                for (int r = 0; r < 4; ++r)
#pragma unroll
                    for (int j = 0; j < 4; ++j) v[r][j] = *(const f32x4*)(src0 + (size_t)(hb * 4 + r) * 1024 + j * 256);
                __builtin_amdgcn_sched_barrier(0);
#pragma unroll
                for (int r = 0; r < 4; ++r)
#pragma unroll
                    for (int j = 0; j < 4; ++j) st_bf4(xr0 + (size_t)(hb * 4 + r) * 1024 + j * 256, v[r][j]);
            } else {
                u32x2 w[4][4];
#pragma unroll
                for (int r = 0; r < 4; ++r)
#pragma unroll
                    for (int j = 0; j < 4; ++j) w[r][j] = *(const u32x2*)(xr0 + (size_t)(hb * 4 + r) * 1024 + j * 256);
                __builtin_amdgcn_sched_barrier(0);
#pragma unroll
                for (int r = 0; r < 4; ++r)
#pragma unroll
                    for (int j = 0; j < 4; ++j) v[r][j] = (f32x4){bflo(w[r][j][0]), bfhi(w[r][j][0]), bflo(w[r][j][1]), bfhi(w[r][j][1])};
            }
            if (part && row0 >= NLAT) {
#pragma unroll
                for (int r = 0; r < 4; ++r) { const size_t o = (size_t)(row0 - NLAT + hb * 4 + r) * 1024 + lane * 4;
#pragma unroll
                    for (int j = 0; j < 4; ++j) { const f32x4 g4 = *(const f32x4*)(pgate + j * 256 + lane * 4);
                        const f32x4 p0 = *(const f32x4*)(part + o + j * 256), p1 = *(const f32x4*)(part + (size_t)NCTX * 1024 + o + j * 256), p2 = *(const f32x4*)(part + (size_t)2 * NCTX * 1024 + o + j * 256), p3 = *(const f32x4*)(part + (size_t)3 * NCTX * 1024 + o + j * 256);
                        v[r][j] += g4 * ((p0 + p1) + (p2 + p3)); st_bf4(xr0 + (size_t)(hb * 4 + r) * 1024 + j * 256, v[r][j]); } }
                __builtin_amdgcn_sched_barrier(0); }
#pragma unroll
            for (int r = 0; r < 4; ++r) { float ss = 0.f;
#pragma unroll
                for (int j = 0; j < 4; ++j) ss += v[r][j][0] * v[r][j][0] + v[r][j][1] * v[r][j][1] + v[r][j][2] * v[r][j][2] + v[r][j][3] * v[r][j][3];
                ss = wave_sum(ss, lane); const float rstd = rsqrtf(ss * (1.f / 1024.f) + 1e-6f);
#pragma unroll
                for (int j = 0; j < 4; ++j) st_bf4(H + (size_t)(row0 + hb * 4 + r) * 1024 + j * 256 + lane * 4, v[r][j] * rstd * mul[j] + add[j]); }
            __builtin_amdgcn_sched_barrier(0);
        }
    }
}

__device__ __forceinline__ void final_phase(const int wv, const bf16_t* __restrict__ xb, float* __restrict__ out, const float* __restrict__ gw) {
    const int tid = ltid(wv); const int lane = tid & 63, wid = tid >> 6; const int gwv = blockIdx.x * 8 + wid, nwv = gridDim.x * 8;
    f32x4 g4[4];
#pragma unroll
    for (int j = 0; j < 4; ++j) g4[j] = *(const f32x4*)(gw + j * 256 + lane * 4);
    for (int task = gwv; task < NLAT / 4; task += nwv) { const bf16_t* src = xb + (size_t)task * 4 * 1024 + lane * 4; float* dst = out + (size_t)task * 4 * 1024 + lane * 4; u32x2 w[4][4];
#pragma unroll
        for (int r = 0; r < 4; ++r)
#pragma unroll
            for (int j = 0; j < 4; ++j) w[r][j] = *(const u32x2*)(src + (size_t)r * 1024 + j * 256);
        __builtin_amdgcn_sched_barrier(0);
#pragma unroll
        for (int r = 0; r < 4; ++r) { f32x4 v[4]; float ss = 0.f;
#pragma unroll
            for (int j = 0; j < 4; ++j) { v[j] = (f32x4){bflo(w[r][j][0]), bfhi(w[r][j][0]), bflo(w[r][j][1]), bfhi(w[r][j][1])}; ss += v[j][0] * v[j][0] + v[j][1] * v[j][1] + v[j][2] * v[j][2] + v[j][3] * v[j][3]; }
            ss = wave_sum(ss, lane); const float rstd = rsqrtf(ss * (1.f / 1024.f) + 1e-6f);
#pragma unroll
            for (int j = 0; j < 4; ++j) *(f32x4*)(dst + (size_t)r * 1024 + j * 256) = v[j] * rstd * g4[j]; }
        __builtin_amdgcn_sched_barrier(0); }
}

__device__ __forceinline__ void qknorm_phase(const int wv, const bf16_t* raw, bf16_t* Q, bf16_t* KB, bf16_t* VB, const float* qg, const float* kg, char* lds) {
    float* ctab = (float*)lds; float* stab = ctab + 2048; const int tid = ltid(wv), lane = tid & 63, wid = tid >> 6;
    for (int i = tid; i < 2048; i += 512) { const int pos = i >> 5, j = i & 31; const float inv = powf(10000.f, -(float)j * (1.f / 32.f)); const float ang = (float)pos * inv; float s, c; sincosf(ang, &s, &c); ctab[i] = c; stab[i] = s; }
    __syncthreads();
    const int gwv = blockIdx.x * 8 + wid, nwv = gridDim.x * 8; const int l16 = lane & 15; const int nwt = NTOK * 12 / 4;
    for (int wt0 = gwv * 4; wt0 < nwt; wt0 += nwv * 4) {
        u32x4 wv[4];
#pragma unroll
        for (int q = 0; q < 4; ++q) { const int tk = (wt0 + q) * 4 + (lane >> 4); const int row = tk / 12, hs = tk - row * 12; wv[q] = *(const u32x4*)(raw + (size_t)row * 1536 + hs * 128 + l16 * 8); }
        __builtin_amdgcn_sched_barrier(0);
#pragma unroll
        for (int q = 0; q < 4; ++q) {
            const int tk = (wt0 + q) * 4 + (lane >> 4); const int row = tk / 12, hs = tk - row * 12; const u32x4 w = wv[q];
            float y[8] = {bflo(w[0]), bfhi(w[0]), bflo(w[1]), bfhi(w[1]), bflo(w[2]), bfhi(w[2]), bflo(w[3]), bfhi(w[3])};
            float ss = 0.f;
#pragma unroll
            for (int e = 0; e < 8; ++e) ss += y[e] * y[e];
            ss += lane_xor(ss, lane, 1); ss += lane_xor(ss, lane, 2); ss += lane_xor(ss, lane, 4); ss += lane_xor(ss, lane, 8);
            int krow;
            if (row < NLAT) krow = (row >> 12) * SKV + (row & 4095); else { const int rc = row - NLAT; krow = (rc >> 8) * SKV + SEQ + (rc & 255); }
            if (hs < 10) {
                const float rstd = rsqrtf(ss * (1.f / 128.f) + 1e-6f); const float* gp = (hs < 8 ? qg : kg) + l16 * 8;
#pragma unroll
                for (int e = 0; e < 8; ++e) y[e] = y[e] * rstd * gp[e];
                if (row < NLAT) { const int t = row & 4095, ri = t >> 6, ci = t & 63;
#pragma unroll
                    for (int pp = 0; pp < 4; ++pp) { const int i = l16 * 4 + pp; const int pos = i < 32 ? ri : ci; const int j = i & 31; const float cs = ctab[pos * 32 + j], sn = stab[pos * 32 + j];
                        const float y0 = y[2 * pp], y1 = y[2 * pp + 1]; y[2 * pp] = y0 * cs - y1 * sn; y[2 * pp + 1] = y0 * sn + y1 * cs; } }
                const u32x4 o = {cvtpk(y[0], y[1]), cvtpk(y[2], y[3]), cvtpk(y[4], y[5]), cvtpk(y[6], y[7])};
                if (hs < 8) *(u32x4*)(Q + (size_t)row * 1024 + hs * 128 + l16 * 8) = o;
                else *(u32x4*)(KB + (size_t)krow * 256 + (hs - 8) * 128 + l16 * 8) = o;
            } else *(u32x4*)(VB + (size_t)krow * 256 + (hs - 10) * 128 + l16 * 8) = w;
        }
        __builtin_amdgcn_sched_barrier(0);
    }
    __syncthreads();
}

__device__ __forceinline__ void attn_phase(const int wv, const bf16_t* Q, const bf16_t* KB, const bf16_t* VB, bf16_t* O, char* lds) {
    const int G = gridDim.x;
    for (int u = blockIdx.x; u < 2048 + 128; u += G) {
        if (u < 2048) {
            int qb, gh;
            if (G == 256) { const int w = u & 255, rnd = u >> 8; const int xcd = w & 7, slot = w >> 3; gh = rnd * 16 + 2 * xcd + (slot >> 4); qb = slot & 15; }
            else { qb = u & 15; gh = u >> 4; }
            const int h = gh & 7, b = gh >> 3; const int kvh = h >> 2;
            const size_t q0 = ((size_t)b * SEQ + qb * 256) * 1024 + h * 128; const size_t k0 = (size_t)b * SKV * 256 + kvh * 128;
            at::attn_dense_body(wv, Q + q0, KB + k0, VB + k0, O + q0, SKV, lds);
        } else { const int v = u - 2048; const int h = v & 7, b = v >> 3; const int kvh = h >> 2;
            const size_t q0 = ((size_t)NLAT + b * 256) * 1024 + h * 128; const size_t k0 = ((size_t)b * SKV + SEQ) * 256 + kvh * 128;
            at::attn_dense_body(wv, Q + q0, KB + k0, VB + k0, O + q0, TCTX, lds); }
        __syncthreads();
    }
}

__device__ __forceinline__ void conv_phase(const int wv, const bf16_t* __restrict__ XR, bf16_t* __restrict__ XC, const float* __restrict__ cw, const float* __restrict__ cb) {
    const int total = (NTOK / 8) * 160; const int tid_ = ltid(wv);
    for (int idx = blockIdx.x * 512 + tid_; idx < total; idx += gridDim.x * 512) {
        const int rb = idx / 160, v = idx - rb * 160, ch0 = v * 8, row0 = rb * 8; int t0, T;
        if (row0 < NLAT) { t0 = row0 & 4095; T = SEQ; } else { t0 = (row0 - NLAT) & 255; T = TCTX; }
        u32x4 xw[11];
#pragma unroll
        for (int i = 0; i < 11; ++i) { const int tt = t0 + i - 2; xw[i] = (tt >= 0 && tt < T) ? *(const u32x4*)(XR + (size_t)(row0 + i - 2) * DRNN + ch0) : (u32x4){0u, 0u, 0u, 0u}; }
        f32x4 wk[4][2], bb[2];
#pragma unroll
        for (int k = 0; k < 4; ++k) { wk[k][0] = *(const f32x4*)(cw + k * DRNN + ch0); wk[k][1] = *(const f32x4*)(cw + k * DRNN + ch0 + 4); }
        bb[0] = *(const f32x4*)(cb + ch0); bb[1] = *(const f32x4*)(cb + ch0 + 4);
        __builtin_amdgcn_sched_barrier(0);
#pragma unroll
        for (int r = 0; r < 8; ++r) { f32x4 a0 = bb[0], a1 = bb[1];
#pragma unroll
            for (int k = 0; k < 4; ++k) { const u32x4 w = xw[r + k];
                a0 += wk[k][0] * (f32x4){bflo(w[0]), bfhi(w[0]), bflo(w[1]), bfhi(w[1])}; a1 += wk[k][1] * (f32x4){bflo(w[2]), bfhi(w[2]), bflo(w[3]), bfhi(w[3])}; }
            const u32x4 o = {cvtpk(a0[0], a0[1]), cvtpk(a0[2], a0[3]), cvtpk(a1[0], a1[1]), cvtpk(a1[2], a1[3])};
            *(u32x4*)(XC + (size_t)(row0 + r) * DRNN + ch0) = o; }
    }
}

__device__ __forceinline__ void scan_phase(const int wv, int dir, const bf16_t* LA, const bf16_t* U, bf16_t* R, bf16_t* Gb, char* lds) {
    float* sA = (float*)lds; float* sH = sA + 512; const int tid = ltid(wv), lane = tid & 63, wid = tid >> 6;
    constexpr int CH = SKV / 8;
    for (int task = blockIdx.x; task < NBATCH * 20; task += gridDim.x) {
        const int b = task / 20, cgp = task - b * 20; const int ch = cgp * 64 + lane;
        const int s_begin = wid * CH;
        float sumla = 0.f, hh = 0.f;
        for (int s0 = s_begin; s0 < s_begin + CH; s0 += 16) {
            long row0; int st;
            if (dir == 0) { st = 1; row0 = s0 < TCTX ? (long)NLAT + b * TCTX + s0 : (long)b * SEQ + (s0 - TCTX); }
            else { st = -1; row0 = s0 < TCTX ? (long)NLAT + b * TCTX + (TCTX - 1 - s0) : (long)b * SEQ + (SEQ - 1 - (s0 - TCTX)); }
            bf16_t la[16], uu[16];
#pragma unroll
            for (int k = 0; k < 16; ++k) { const size_t o = (size_t)(row0 + (long)st * k) * DRNN + ch; la[k] = LA[o]; uu[k] = U[o]; }
#pragma unroll
            for (int k = 0; k < 16; ++k) { const float l = bf1(la[k]); const float a = __builtin_amdgcn_exp2f(l * 1.4426950408889634f); hh = a * hh + __builtin_amdgcn_sqrtf(fmaxf(1.f - a * a, 0.f)) * bf1(uu[k]); sumla += l; }
        }
        sA[wid * 64 + lane] = sumla; sH[wid * 64 + lane] = hh;
        __syncthreads();
        float h = 0.f;
        for (int w2 = 0; w2 < wid; ++w2) h = __expf(sA[w2 * 64 + lane]) * h + sH[w2 * 64 + lane];
        for (int s0 = s_begin; s0 < s_begin + CH; s0 += 16) {
            long row0; int st;
            if (dir == 0) { st = 1; row0 = s0 < TCTX ? (long)NLAT + b * TCTX + s0 : (long)b * SEQ + (s0 - TCTX); }
            else { st = -1; row0 = s0 < TCTX ? (long)NLAT + b * TCTX + (TCTX - 1 - s0) : (long)b * SEQ + (SEQ - 1 - (s0 - TCTX)); }
            const bool live = s0 >= TCTX;
            bf16_t la[16], uu[16], ex[16];
#pragma unroll
            for (int k = 0; k < 16; ++k) { const size_t o = (size_t)(row0 + (long)st * k) * DRNN + ch; la[k] = LA[o]; uu[k] = U[o]; }
            if (dir == 1 && live) {
#pragma unroll
                for (int k = 0; k < 16; ++k) { const size_t o = (size_t)(row0 + (long)st * k) * DRNN + ch; ex[k] = R[o]; la[k] = la[k]; }
            }
            bf16_t gg[16];
            if (dir == 1 && live) {
#pragma unroll
                for (int k = 0; k < 16; ++k) { const size_t o = (size_t)(row0 + (long)st * k) * DRNN + ch; gg[k] = Gb[o]; }
            }
#pragma unroll
            for (int k = 0; k < 16; ++k) { const size_t o = (size_t)(row0 + (long)st * k) * DRNN + ch; { const float a = __builtin_amdgcn_exp2f(bf1(la[k]) * 1.4426950408889634f); h = a * h + __builtin_amdgcn_sqrtf(fmaxf(1.f - a * a, 0.f)) * bf1(uu[k]); }
                if (live) { if (dir == 0) R[o] = f2bf(h); else Gb[o] = f2bf(bf1(gg[k]) * (bf1(ex[k]) + h)); } }
        }
        __syncthreads();
    }
}

__global__ __launch_bounds__(512, 2) void mk(Params p_unused, int ph0, int ph1) {
    extern __shared__ __attribute__((aligned(16))) unsigned char shm[];
    LAS unsigned char* lds3 = (LAS unsigned char*)shm; char* lds = (char*)shm;
    int wv = __builtin_amdgcn_readfirstlane((int)(threadIdx.x >> 6)); asm volatile("" : "+s"(wv));
    volatile LAS unsigned* bst = (volatile LAS unsigned*)(lds3 + 131072 + 2048);
    if (ph1 - ph0 > 1) {
        if (ltid(wv) == 0) { bst[0] = 0u; bst[1] = 0u; PP p0 = (PP)__builtin_amdgcn_kernarg_segment_ptr(); (void)xb_add(&((unsigned*)(p0->ws + O_BAR))[XB_XCNT(xb_xcc_id())], 1u); }
        __syncthreads();
    }
    for (int ph = ph0; ph < ph1; ++ph) {
        PP p = (PP)__builtin_amdgcn_kernarg_segment_ptr();
        asm volatile("" : "+s"(p));
        unsigned char* ws = p->ws;
        if (ph0 < 0) cg::this_grid().sync();
        else if (ph > ph0) xcd_barrier(wv, (unsigned*)(ws + O_BAR), bst);
#ifdef ONLY_OP
        const int op = ONLY_OP; const int layer = p->lay[ph];
#else
        const int op = p->op[ph], layer = p->lay[ph];
#endif
        const bool lastl = layer == 3;
        const bool ctx_dead = lastl || (layer == 2 && (op == OP_RES_LOUT || op == OP_NORM_MLP || op == OP_G_MLP1 || op == OP_RES_MLP2));
        const int M = ctx_dead ? NLAT : NTOK;
        const float* modl = (const float*)(ws + O_MOD) + (size_t)layer * 17 * 6144;
        bf16_t* xb = (bf16_t*)(ws + O_XB);
        const int fj = layer == 3 ? 1 : 0;
        switch (op) {
        case OP_PREP: prep_phase(wv, p, lds); break;
        case OP_NORM_MIX: {
            const bool fix = layer == 1 || layer == 2;
            if (layer == 0) norm_phase<true>(wv, p->x, p->ctx, xb, p->norm_mix_g, modl, 0, 1024, (bf16_t*)(ws + O_H), M);
            else norm_phase<false>(wv, nullptr, nullptr, xb, p->norm_mix_g + layer * 1024, modl, 0, 1024, (bf16_t*)(ws + O_H), M, fix ? (const float*)(ws + O_PART) : nullptr,
                                   (const float*)(ws + O_MOD) + ((size_t)(layer - 1) * 17 + 16) * 6144 + 5120);
            if (layer == 0) dmat_gen(wv, (bf16_t*)(ws + O_CST), lds);
        } break;
        case OP_NORM_MLP: norm_phase<false>(wv, nullptr, nullptr, xb, p->norm_mlp_g + layer * 1024, modl, 3072, 4096, (bf16_t*)(ws + O_H), M); break;
        case OP_G_PQ: { EpiPQT E; E.PP = (bf16_t*)(ws + O_PQTP); E.PQ = (bf16_t*)(ws + O_PQTQ); E.P64 = (bf16_t*)(ws + O_PQT64); E.PC = (bf16_t*)(ws + O_PQTC);
            run_gemm(wv, lds3, (const bf16_t*)(ws + O_WPQT) + (size_t)fj * 1024 * 1024, 1024, (const bf16_t*)(ws + O_H), 1024, M, 1024, E); } break;
        case OP_FOLD: fold_phase(wv, (const bf16_t*)(ws + O_PQTP), (bf16_t*)(ws + O_FOLD)); break;
        case OP_G_DFT: case OP_G_DFTC: {
#pragma nounroll
            for (int gi = 0; gi < 3; ++gi) { const int g = gi == 0 ? 2 : gi - 1;
                if (g == 0 && lastl) continue;
                EpiDFTS E; E.F = (bf16_t*)(ws + O_F); E.mode = g == 2 ? 0 : (g == 1 ? 1 : 2); E.scale = g == 0 ? 0.005524271728019903f : 0.0013810679320049757f;
                const bf16_t* A = (const bf16_t*)(ws + (g == 0 ? O_D256 : O_CST)); const bf16_t* Bt = g == 0 ? (const bf16_t*)(ws + O_PQTC) : (const bf16_t*)(ws + O_FOLD) + (g == 1 ? (size_t)16384 * KF : 0);
                const int Mg = g == 0 ? 512 : 2048, Ng = g == 1 ? 256 : 16384, Kg = g == 0 ? 256 : KF;
                pg8::DftOrder S; S.init(Mg, Ng, (int)gridDim.x, g == 1 ? (int)((blockIdx.x + gridDim.x - 128) % gridDim.x) : (int)blockIdx.x); S.kq = g == 2 ? 2048 * KF * 2 : 0; S.kcls = g == 0 ? 0 : (int)FOLD_CLS;
                pg8::Gemm gm; gm.A = A; gm.Bt = Bt; gm.M = Mg; gm.N = Ng; gm.K = Kg; gm.lda = Kg; gm.ldb = Kg;
                pg8::gemm_phase<EpiDFTS, pg8::DftOrder>(wv, lds3, gm, S, E);
            }
            nyquist_pass(wv, (const bf16_t*)(ws + O_PQTP), (const bf16_t*)(ws + O_PQT64), (bf16_t*)(ws + O_F), 0.0013810679320049757f);
        } break;
        case OP_RES_FOUT: case OP_RES_MLP2: case OP_RES_WO: case OP_RES_LOUT: {
            const bool split = (op == OP_RES_MLP2 && layer < 2);
            const bf16_t* A; const bf16_t* Bt; int K;
            if (op == OP_RES_FOUT) { A = (const bf16_t*)(ws + O_F); Bt = (const bf16_t*)(ws + O_FWOT) + (size_t)fj * 1024 * 1024; K = 1024; }
            else if (op == OP_RES_MLP2) { A = (const bf16_t*)(ws + O_BIG); Bt = (const bf16_t*)(ws + O_W2T) + (size_t)layer * DFF * 1024; K = DFF; }
            else if (op == OP_RES_WO) { A = (const bf16_t*)(ws + O_H); Bt = (const bf16_t*)(ws + O_WOT); K = 1024; }
            else { A = (const bf16_t*)(ws + O_G); Bt = (const bf16_t*)(ws + O_LWOT); K = DRNN; }
#pragma nounroll
            for (int g = 0; g < (split ? 2 : 1); ++g) {
                EpiRes E; E.xb = xb; E.gate = modl + (op == OP_RES_MLP2 ? 5120 : 2048);
                E.part = g ? (float*)(ws + O_PART) : nullptr;
                pg8::ResOrder S; S.split = g;
                if (g == 0) S.init(split ? NLAT : M, 1024, (int)gridDim.x, (int)blockIdx.x); else S.init(NCTX, 4096, (int)gridDim.x, (int)blockIdx.x);
                pg8::Gemm gm; gm.A = g ? A + (size_t)NLAT * DFF : A; gm.Bt = Bt; gm.M = 0; gm.N = 0; gm.K = g ? 1024 : K; gm.lda = K; gm.ldb = K;
                pg8::gemm_phase<EpiRes, pg8::ResOrder>(wv, lds3, gm, S, E);
            } } break;
        case OP_G_MLP1: { EpiRelu2 E; E.O = (bf16_t*)(ws + O_BIG); E.ldc = DFF;
            run_gemm(wv, lds3, (const bf16_t*)(ws + O_H), 1024, (const bf16_t*)(ws + O_W1T) + (size_t)layer * DFF * 1024, M, DFF, 1024, E); } break;
        case OP_G_QKV: { EpiQKV E; E.Q = (bf16_t*)(ws + O_Q); E.KB = (bf16_t*)(ws + O_KB); E.VB = (bf16_t*)(ws + O_VB); E.qg = p->q_g; E.kg = p->k_g; E.rope = (const float*)(ws + O_ROPE); E.red = (LAS float*)(lds3 + 131072 + 4096);
            run_gemm(wv, lds3, (const bf16_t*)(ws + O_H), 1024, (const bf16_t*)(ws + O_WQKVT), M, 1536, 1024, E); } break;
        case OP_QKNORM: qknorm_phase(wv, (const bf16_t*)(ws + O_QKVRAW), (bf16_t*)(ws + O_Q), (bf16_t*)(ws + O_KB), (bf16_t*)(ws + O_VB), p->q_g, p->k_g, lds); break;
        case OP_ATTN: attn_phase(wv, (const bf16_t*)(ws + O_Q), (const bf16_t*)(ws + O_KB), (const bf16_t*)(ws + O_VB), (bf16_t*)(ws + O_H), lds); break;
        case OP_G_LRUIN: { EpiLruIn E; E.G = (bf16_t*)(ws + O_G); E.XR = (bf16_t*)(ws + O_XR);
            run_gemm(wv, lds3, (const bf16_t*)(ws + O_H), 1024, (const bf16_t*)(ws + O_LWINT), M, 2560, 1024, E); } break;
        case OP_CONV: conv_phase(wv, (const bf16_t*)(ws + O_XR), (bf16_t*)(ws + O_XCONV), p->conv_w, p->conv_b); break;
        case OP_G_GATE0: case OP_G_GATE1: { const int d = op == OP_G_GATE1 ? 1 : 0;
            EpiGate E; E.XC = (const bf16_t*)(ws + O_XCONV); E.LA = (bf16_t*)(ws + O_LA); E.U = (bf16_t*)p->out; E.gpar = (const float*)(ws + O_GPAR) + (size_t)d * 3 * DRNN;
            run_gemm<EpiGate, pg8::GateOrder>(wv, lds3, (const bf16_t*)(ws + O_XCONV), DRNN, (const bf16_t*)(ws + O_GATET) + (size_t)d * 2560 * 256, M, 2560, 256, E); } break;
        case OP_SCAN0: scan_phase(wv, 0, (const bf16_t*)(ws + O_LA), (const bf16_t*)p->out, (bf16_t*)(ws + O_XR), (bf16_t*)(ws + O_G), lds); break;
        case OP_SCAN1: scan_phase(wv, 1, (const bf16_t*)(ws + O_LA), (const bf16_t*)p->out, (bf16_t*)(ws + O_XR), (bf16_t*)(ws + O_G), lds); break;
        case OP_FINAL: final_phase(wv, xb, p->out, p->final_g); break;
        default: break;
        }
    }
}

extern "C" void kernel_launch(void* const* d_in, const int* in_sizes, int n_in, void* d_out, int out_size, void* d_ws, size_t ws_size, hipStream_t stream) {
    Params p; memset(&p, 0, sizeof(p));
    const float** f = (const float**)&p;
    for (int i = 0; i < 26 && i < n_in; ++i) f[i] = (const float*)d_in[i];
    p.out = (float*)d_out; p.ws = (unsigned char*)d_ws;
    int n = 0;
#ifndef PROBE_DUP
#define PROBE_DUP -1
#endif
    auto add = [&](int op, int layer) { const int reps = (op == PROBE_DUP) ? 2 : 1; for (int r = 0; r < reps; ++r) { p.op[n] = (unsigned char)op; p.lay[n] = (unsigned char)layer; ++n; } };
    add(OP_PREP, 0);
    add(OP_NORM_MIX, 0); add(OP_G_PQ, 0); add(OP_FOLD, 0); add(OP_G_DFT, 0); add(OP_RES_FOUT, 0); add(OP_NORM_MLP, 0); add(OP_G_MLP1, 0); add(OP_RES_MLP2, 0);
    add(OP_NORM_MIX, 1); add(OP_G_QKV, 1); add(OP_ATTN, 1); add(OP_RES_WO, 1); add(OP_NORM_MLP, 1); add(OP_G_MLP1, 1); add(OP_RES_MLP2, 1);
    add(OP_NORM_MIX, 2); add(OP_G_LRUIN, 2); add(OP_CONV, 2); add(OP_G_GATE0, 2); add(OP_SCAN0, 2); add(OP_G_GATE1, 2); add(OP_SCAN1, 2); add(OP_RES_LOUT, 2);
    add(OP_NORM_MLP, 2); add(OP_G_MLP1, 2); add(OP_RES_MLP2, 2);
    add(OP_NORM_MIX, 3); add(OP_G_PQ, 3); add(OP_FOLD, 3); add(OP_G_DFT, 3); add(OP_RES_FOUT, 3); add(OP_NORM_MLP, 3); add(OP_G_MLP1, 3); add(OP_RES_MLP2, 3);
    add(OP_FINAL, 3);
    static int grid = 0;
    if (!grid) {
        hipFuncSetAttribute((const void*)mk, hipFuncAttributeMaxDynamicSharedMemorySize, LDS_BYTES);
        int dev = 0, cus = 0, per_cu = 0; hipGetDevice(&dev); hipDeviceGetAttribute(&cus, hipDeviceAttributeMultiprocessorCount, dev);
        hipOccupancyMaxActiveBlocksPerMultiprocessor(&per_cu, mk, 512, LDS_BYTES);
        if (per_cu < 1) { fprintf(stderr, "occupancy query returned %d\n", per_cu); per_cu = 1; }
        grid = cus > 0 ? cus : 256;
    }
#if MK_LAUNCHES == 1
    hipMemsetAsync((char*)d_ws + O_BAR, 0, BAR_BYTES, stream);
    int ph0 = 0, ph1 = n; void* args[] = {&p, &ph0, &ph1};
    hipError_t e = hipLaunchCooperativeKernel((void*)mk, dim3(grid), dim3(512), args, LDS_BYTES, stream);
    if (e != hipSuccess) fprintf(stderr, "cooperative launch failed: %s\n", hipGetErrorString(e));
#else
    for (int ph = 0; ph < n; ++ph) hipLaunchKernelGGL(mk, dim3(grid), dim3(512), LDS_BYTES, stream, p, ph, ph + 1);
#endif
}
```
